# Optimizing an MI355X kernel written in HIP

```python
import math
import jax, jax.numpy as jnp
from jax import lax
import numpy as np

D_MODEL = 1024
BATCH = 16
SEQ = 4096
DEPTH = 2

N_META = 16
BLOCK = 128
PAD_LEN = BLOCK - N_META
EPS = 1e-6
NEG_INF = -1e30

N_BRANCH = 4
D_BRANCH = 256

FOX_HEADS = 4
FOX_DH = 64

MLA_HEADS = 4
MLA_NOPE = 64
MLA_ROPE = 32
MLA_DV = 64
MLA_Q_RANK = 192
MLA_KV_RANK = 128
ROPE_BASE = 10000.0

GDN_HEADS = 4
GDN_DK = 64
GDN_DV = 64
GDN_CONV = 4
GDN_CHUNK = 64

LRU_WIDTH = 256
LRU_BLOCKS = 4
LRU_CONV = 4
LRU_C = 8.0

D_FF = 2816

OFF_FOX_QKV = 0
OFF_FOX_F = OFF_FOX_QKV + 3 * FOX_HEADS * FOX_DH
OFF_MLA_CQ = OFF_FOX_F + FOX_HEADS
OFF_MLA_CKV = OFF_MLA_CQ + MLA_Q_RANK
OFF_MLA_KR = OFF_MLA_CKV + MLA_KV_RANK
OFF_GDN_QKV = OFF_MLA_KR + MLA_ROPE
OFF_GDN_A = OFF_GDN_QKV + GDN_HEADS * (2 * GDN_DK + GDN_DV)
OFF_GDN_B = OFF_GDN_A + GDN_HEADS
OFF_GDN_G = OFF_GDN_B + GDN_HEADS
OFF_LRU = OFF_GDN_G + GDN_HEADS * GDN_DV
N_IN = OFF_LRU + LRU_WIDTH

kernel_name = "hybrid_fox_mla_gdn_rglru_macaron"


def rmsnorm(x, g):
    xf = x.astype(jnp.float32)
    y = xf * lax.rsqrt(jnp.mean(xf * xf, axis=-1, keepdims=True) + EPS)
    return y.astype(x.dtype) * g


def l2norm(x):
    return x * lax.rsqrt(jnp.sum(x * x, axis=-1, keepdims=True) + EPS)


def swiglu(h, wi, wo):
    gu = h @ wi
    g, u = jnp.split(gu, 2, axis=-1)
    return (jax.nn.silu(g) * u) @ wo


def causal_dwconv(x, w):
    K, C = w.shape
    return lax.conv_general_dilated(
        x, w[:, None, :].astype(x.dtype), window_strides=(1,), padding=[(K - 1, 0)],
        dimension_numbers=('NWC', 'WIO', 'NWC'), feature_group_count=C)


def rope(x, cos, sin):
    half = x.shape[-1] // 2
    x1, x2 = x[..., :half], x[..., half:]
    return jnp.concatenate([x1 * cos - x2 * sin, x2 * cos + x1 * sin], axis=-1)


def blocked_causal_attention(q, k, v, scale, cum=None):
    B, H, T, dk = q.shape
    nb = T // BLOCK
    kpos = jnp.arange(T)
    key_ok = kpos >= PAD_LEN
    q_blocks = jnp.moveaxis(q.reshape(B, H, nb, BLOCK, dk), 2, 0)
    xs = (jnp.arange(nb), q_blocks)
    if cum is not None:
        xs = xs + (jnp.moveaxis(cum.reshape(B, H, nb, BLOCK), 2, 0),)

    def one_block(blk):
        i, q_i = blk[0], blk[1]
        s = jnp.einsum('bhqd,bhkd->bhqk', q_i, k, preferred_element_type=jnp.float32) * scale
        if cum is not None:
            s = s + blk[2][..., :, None] - cum[:, :, None, :]
        qpos = i * BLOCK + jnp.arange(BLOCK)
        mask = (kpos[None, :] <= qpos[:, None]) & key_ok[None, :]
        s = jnp.where(mask, s, NEG_INF)
        prob = jax.nn.softmax(s, axis=-1)
        return jnp.einsum('bhqk,bhkd->bhqd', prob.astype(v.dtype), v)

    out = lax.map(one_block, xs)
    return jnp.moveaxis(out, 0, 2).reshape(B, H, T, v.shape[-1])


def fox_branch(p, b_f):
    B, T, _ = p.shape
    qkv = p[..., OFF_FOX_QKV:OFF_FOX_F].reshape(B, T, 3, FOX_HEADS, FOX_DH)
    q = qkv[:, :, 0].transpose(0, 2, 1, 3)
    k = qkv[:, :, 1].transpose(0, 2, 1, 3)
    v = qkv[:, :, 2].transpose(0, 2, 1, 3)
    log_f = jax.nn.log_sigmoid((p[..., OFF_FOX_F:OFF_MLA_CQ] + b_f).astype(jnp.float32))
    cum = jnp.cumsum(log_f, axis=1).transpose(0, 2, 1)
    o = blocked_causal_attention(q, k, v, FOX_DH ** -0.5, cum)
    return o.transpose(0, 2, 1, 3).reshape(B, T, FOX_HEADS * FOX_DH)


def mla_branch(p, g_qn, w_q_up, g_kvn, w_kv_up, cos, sin):
    B, T, _ = p.shape
    cq = rmsnorm(p[..., OFF_MLA_CQ:OFF_MLA_CKV], g_qn)
    q = (cq @ w_q_up).reshape(B, T, MLA_HEADS, MLA_NOPE + MLA_ROPE)
    ckv = rmsnorm(p[..., OFF_MLA_CKV:OFF_MLA_KR], g_kvn)
    kv = (ckv @ w_kv_up).reshape(B, T, MLA_HEADS, MLA_NOPE + MLA_DV)
    k_rope = rope(p[..., OFF_MLA_KR:OFF_GDN_QKV], cos, sin)
    q_rope = rope(q[..., MLA_NOPE:], cos[:, None], sin[:, None])
    q = jnp.concatenate([q[..., :MLA_NOPE], q_rope], axis=-1)
    k = jnp.concatenate([kv[..., :MLA_NOPE],
                         jnp.broadcast_to(k_rope[:, :, None], (B, T, MLA_HEADS, MLA_ROPE))], axis=-1)
    v = kv[..., MLA_NOPE:]
    o = blocked_causal_attention(q.transpose(0, 2, 1, 3), k.transpose(0, 2, 1, 3),
                                 v.transpose(0, 2, 1, 3), (MLA_NOPE + MLA_ROPE) ** -0.5)
    return o.transpose(0, 2, 1, 3).reshape(B, T, MLA_HEADS * MLA_DV)


def gdn_branch(p, conv_w, a_log, dt_bias, g_on):
    B, T, _ = p.shape
    H, DK, DV, C = GDN_HEADS, GDN_DK, GDN_DV, GDN_CHUNK
    f32 = jnp.float32
    qkv = jax.nn.silu(causal_dwconv(p[..., OFF_GDN_QKV:OFF_GDN_A], conv_w)).astype(f32)
    q = l2norm(qkv[..., :H * DK].reshape(B, T, H, DK)) * DK ** -0.5
    k = l2norm(qkv[..., H * DK:2 * H * DK].reshape(B, T, H, DK))
    v = qkv[..., 2 * H * DK:].reshape(B, T, H, DV)
    beta = jax.nn.sigmoid(p[..., OFF_GDN_B:OFF_GDN_G].astype(f32))
    g = -jnp.exp(a_log.astype(f32)) * jax.nn.softplus(
        p[..., OFF_GDN_A:OFF_GDN_B].astype(f32) + dt_bias.astype(f32))
    nc = T // C

    def chunks(t):
        return jnp.moveaxis(t, 2, 1).reshape((B, H, nc, C) + t.shape[3:])

    q, k, v, beta, g = chunks(q), chunks(k), chunks(v), chunks(beta), chunks(g)
    G = jnp.cumsum(g, axis=-1)
    idx = jnp.arange(C)
    strict = idx[:, None] > idx[None, :]
    incl = idx[:, None] >= idx[None, :]
    decay = jnp.exp(jnp.where(incl, G[..., :, None] - G[..., None, :], NEG_INF))
    kb = k * beta[..., None]
    vb = v * beta[..., None]
    m = jnp.eye(C, dtype=f32) + jnp.where(
        strict, jnp.einsum('bhnik,bhnjk->bhnij', kb, k) * decay, 0.0)
    rhs = jnp.concatenate([kb * jnp.exp(G)[..., None], vb], axis=-1)
    sol = lax.linalg.triangular_solve(m, rhs, left_side=True, lower=True, unit_diagonal=True)
    w, u = sol[..., :DK], sol[..., DK:]
    qk = jnp.where(incl, jnp.einsum('bhnik,bhnjk->bhnij', q, k) * decay, 0.0)
    q_dec = q * jnp.exp(G)[..., None]
    k_dec = k * jnp.exp(G[..., -1:] - G)[..., None]
    g_last = jnp.exp(G[..., -1])
    xs = (jnp.moveaxis(q_dec, 2, 0), jnp.moveaxis(k_dec, 2, 0), jnp.moveaxis(w, 2, 0),
          jnp.moveaxis(u, 2, 0), jnp.moveaxis(qk, 2, 0), jnp.moveaxis(g_last, 2, 0))

    def step(S, inp):
        q_c, k_c, w_c, u_c, qk_c, gl_c = inp
        v_new = u_c - jnp.einsum('bhck,bhkv->bhcv', w_c, S)
        o_c = jnp.einsum('bhck,bhkv->bhcv', q_c, S) + jnp.einsum('bhij,bhjv->bhiv', qk_c, v_new)
        S = S * gl_c[..., None, None] + jnp.einsum('bhck,bhcv->bhkv', k_c, v_new)
        return S, o_c

    S0 = jnp.zeros((B, H, DK, DV), f32)
    _, o = lax.scan(step, S0, xs)
    o = jnp.moveaxis(o, 0, 2).reshape(B, H, T, DV).transpose(0, 2, 1, 3)
    gate = jax.nn.silu(p[..., OFF_GDN_G:OFF_LRU].astype(f32)).reshape(B, T, H, DV)
    o = rmsnorm(o, g_on) * gate
    return o.reshape(B, T, H * DV).astype(p.dtype)


def rglru_branch(p, valid, conv_w, conv_b, w_a, b_a, w_x, b_x, lam):
    B, T, _ = p.shape
    f32 = jnp.float32
    xr = causal_dwconv(p[..., OFF_LRU:N_IN], conv_w) + conv_b
    xr = jnp.where(valid[None, :, None], xr, 0)
    xb = xr.reshape(B, T, LRU_BLOCKS, LRU_WIDTH // LRU_BLOCKS)
    r = jax.nn.sigmoid(jnp.einsum('btni,nij->btnj', xb, w_a).reshape(B, T, LRU_WIDTH) + b_a).astype(f32)
    ig = jax.nn.sigmoid(jnp.einsum('btni,nij->btnj', xb, w_x).reshape(B, T, LRU_WIDTH) + b_x).astype(f32)
    log_a = -LRU_C * r * jax.nn.softplus(-lam.astype(f32))
    a = jnp.exp(log_a)
    b = jnp.sqrt(-jnp.expm1(2.0 * log_a)) * ig * xr.astype(f32)

    def combine(e1, e2):
        return (e1[0] * e2[0], e2[0] * e1[1] + e2[1])

    _, h = lax.associative_scan(combine, (a, b), axis=1)
    return h.astype(p.dtype)


def hybrid_mixer(u, valid, cos, sin, w_in, fox_bf, mla_gq, mla_wq, mla_gkv, mla_wkv,
                 gdn_conv, gdn_alog, gdn_dtb, gdn_gon, lru_conv, lru_conv_b, lru_wa, lru_ba,
                 lru_wx, lru_bx, lru_lam, w_gate, b_gate, w_branch, w_out):
    p = u @ w_in
    ys = (fox_branch(p, fox_bf),
          mla_branch(p, mla_gq, mla_wq, mla_gkv, mla_wkv, cos, sin),
          gdn_branch(p, gdn_conv, gdn_alog, gdn_dtb, gdn_gon),
          rglru_branch(p, valid, lru_conv, lru_conv_b, lru_wa, lru_ba, lru_wx, lru_bx, lru_lam))
    merged = jax.nn.sigmoid(u @ w_gate[0] + b_gate[0]) * (ys[0] @ w_branch[0])
    for n in range(1, N_BRANCH):
        merged = merged + jax.nn.sigmoid(u @ w_gate[n] + b_gate[n]) * (ys[n] @ w_branch[n])
    return merged @ w_out


def setup_inputs(seed: int = 0) -> dict:
    key = jax.random.key(seed)
    k = jax.random.split(key, 32)
    f32 = jnp.float32
    D, L, F = D_MODEL, DEPTH, D_FF

    def nrm(i, shape, scale):
        return scale * jax.random.normal(k[i], shape, f32)

    def gain(i, shape):
        return 1.0 + 0.02 * jax.random.normal(k[i], shape, f32)

    u_a = jax.random.uniform(k[22], (L, LRU_WIDTH), f32, 0.9, 0.999)
    a_base = u_a ** (1.0 / LRU_C)
    lru_lam = jnp.log(a_base) - jnp.log1p(-a_base)
    dt = jnp.exp(jax.random.uniform(k[14], (L, GDN_HEADS), f32, math.log(1e-3), math.log(1e-1)))
    gdn_dtb = dt + jnp.log(-jnp.expm1(-dt))
    gdn_alog = jnp.log(jax.random.uniform(k[13], (L, GDN_HEADS), f32, 1.0, 16.0))
    return {
        "x": nrm(0, (BATCH, SEQ, D), 1.0),
        "meta": nrm(1, (N_META, D), 1.0),
        "ln_ffn1": gain(2, (L, D)),
        "ffn1_wi": nrm(3, (L, D, 2 * F), D ** -0.5),
        "ffn1_wo": nrm(4, (L, F, D), F ** -0.5),
        "ln_mix": gain(5, (L, D)),
        "w_in": nrm(6, (L, D, N_IN), D ** -0.5),
        "fox_bf": 3.0 + nrm(7, (L, FOX_HEADS), 0.1),
        "mla_gq": gain(8, (L, MLA_Q_RANK)),
        "mla_wq": nrm(9, (L, MLA_Q_RANK, MLA_HEADS * (MLA_NOPE + MLA_ROPE)), MLA_Q_RANK ** -0.5),
        "mla_gkv": gain(10, (L, MLA_KV_RANK)),
        "mla_wkv": nrm(11, (L, MLA_KV_RANK, MLA_HEADS * (MLA_NOPE + MLA_DV)), MLA_KV_RANK ** -0.5),
        "gdn_conv": nrm(12, (L, GDN_CONV, GDN_HEADS * (2 * GDN_DK + GDN_DV)), GDN_CONV ** -0.5),
        "gdn_alog": gdn_alog,
        "gdn_dtb": gdn_dtb,
        "gdn_gon": gain(15, (L, GDN_DV)),
        "lru_conv": nrm(16, (L, LRU_CONV, LRU_WIDTH), LRU_CONV ** -0.5),
        "lru_conv_b": nrm(17, (L, LRU_WIDTH), 0.01),
        "lru_wa": nrm(18, (L, LRU_BLOCKS, LRU_WIDTH // LRU_BLOCKS, LRU_WIDTH // LRU_BLOCKS), (LRU_WIDTH // LRU_BLOCKS) ** -0.5),
        "lru_ba": nrm(19, (L, LRU_WIDTH), 0.01),
        "lru_wx": nrm(20, (L, LRU_BLOCKS, LRU_WIDTH // LRU_BLOCKS, LRU_WIDTH // LRU_BLOCKS), (LRU_WIDTH // LRU_BLOCKS) ** -0.5),
        "lru_bx": nrm(21, (L, LRU_WIDTH), 0.01),
        "lru_lam": lru_lam,
        "w_gate": nrm(23, (L, N_BRANCH, D, D), D ** -0.5),
        "b_gate": nrm(24, (L, N_BRANCH, D), 0.01),
        "w_branch": nrm(25, (L, N_BRANCH, D_BRANCH, D), D_BRANCH ** -0.5),
        "w_out": nrm(26, (L, D, D), D ** -0.5),
        "ln_ffn2": gain(27, (L, D)),
        "ffn2_wi": nrm(28, (L, D, 2 * F), D ** -0.5),
        "ffn2_wo": nrm(29, (L, F, D), F ** -0.5),
        "ln_final": gain(30, (D,)),
    }


def reference(x, meta, ln_ffn1, ffn1_wi, ffn1_wo, ln_mix, w_in, fox_bf, mla_gq, mla_wq,
              mla_gkv, mla_wkv, gdn_conv, gdn_alog, gdn_dtb, gdn_gon, lru_conv, lru_conv_b,
              lru_wa, lru_ba, lru_wx, lru_bx, lru_lam, w_gate, b_gate, w_branch, w_out,
              ln_ffn2, ffn2_wi, ffn2_wo, ln_final):
    B, S, D = x.shape
    T = BLOCK + S
    h = jnp.concatenate([jnp.zeros((B, PAD_LEN, D), x.dtype),
                         jnp.broadcast_to(meta.astype(x.dtype)[None], (B, N_META, D)), x], axis=1)
    pos = jnp.arange(T)
    valid = pos >= PAD_LEN
    rel = (pos - PAD_LEN).astype(jnp.float32)
    inv_freq = ROPE_BASE ** (-(jnp.arange(0, MLA_ROPE, 2, dtype=jnp.float32) / MLA_ROPE))
    ang = rel[:, None] * inv_freq[None, :]
    cos = jnp.cos(ang).astype(x.dtype)
    sin = jnp.sin(ang).astype(x.dtype)
    for l in range(DEPTH):
        h = h + 0.5 * swiglu(rmsnorm(h, ln_ffn1[l]), ffn1_wi[l], ffn1_wo[l])
        u = jnp.where(valid[None, :, None], rmsnorm(h, ln_mix[l]), 0)
        h = h + hybrid_mixer(u, valid, cos, sin, w_in[l], fox_bf[l], mla_gq[l], mla_wq[l],
                             mla_gkv[l], mla_wkv[l], gdn_conv[l], gdn_alog[l], gdn_dtb[l],
                             gdn_gon[l], lru_conv[l], lru_conv_b[l], lru_wa[l], lru_ba[l],
                             lru_wx[l], lru_bx[l], lru_lam[l], w_gate[l], b_gate[l],
                             w_branch[l], w_out[l])
        h = h + 0.5 * swiglu(rmsnorm(h, ln_ffn2[l]), ffn2_wi[l], ffn2_wo[l])
    y = rmsnorm(h, ln_final)
    return y[:, BLOCK:]
```

```cpp
#include <hip/hip_runtime.h>
#include <hip/hip_cooperative_groups.h>
#include <cstdio>
#include <cstring>
namespace cg = cooperative_groups;

#ifndef GK_MASK
#define GK_MASK 0xff
#endif
#ifndef EN_MASK
#define EN_MASK 0xff
#endif
#ifndef ONE_LAUNCH
#define ONE_LAUNCH 1
#endif

#define LAS __attribute__((address_space(3)))
typedef unsigned short bf16_t;
typedef short bf16x8 __attribute__((ext_vector_type(8)));
typedef float f32x4 __attribute__((ext_vector_type(4)));
typedef float f32x16 __attribute__((ext_vector_type(16)));
typedef unsigned u32x4 __attribute__((ext_vector_type(4)));
typedef unsigned u32x2 __attribute__((ext_vector_type(2)));

constexpr int NB = 16, TT = 4224, NT = NB * TT, DM = 1024, FF = 2816, PADL = 112, PN = 2560;
constexpr int HR = NT / 2;
constexpr float EPS = 1e-6f, LOG2E = 1.4426950408889634f;
constexpr int NTHR = 512, LDS_BYTES = 131072;
constexpr int PC_FQ = 0, PC_FK = 256, PC_FV = 512, PC_CQ = 768, PC_CKV = 960, PC_KR = 1088, PC_GQ = 1120, PC_GK = 1376, PC_GV = 1632,
              PC_GG = 1888, PC_LRU = 2144, PC_FF = 2400, PC_GA = 2404, PC_GB = 2408;
constexpr size_t W_WI1 = 0, W_WO1 = W_WI1 + 5632ull * 1024 * 2, W_WI2 = W_WO1 + 1024ull * 2816 * 2, W_WO2 = W_WI2 + 5632ull * 1024 * 2,
                 W_WIN = W_WO2 + 1024ull * 2816 * 2, W_WUP = W_WIN + 2560ull * 1024 * 2, W_WG = W_WUP + 1024ull * 384 * 2,
                 W_WB = W_WG + 4096ull * 1024 * 2, W_WOUT = W_WB + 4096ull * 256 * 2, W_LAYER = W_WOUT + 1024ull * 1024 * 2;
constexpr size_t OFF_H = 0, OFF_W = OFF_H + (size_t)NT * DM * 4, OFF_UN = OFF_W + 2 * W_LAYER, OFF_BIG = OFF_UN + (size_t)NT * DM * 2,
                 OFF_REST = OFF_BIG + (size_t)NT * FF * 2;
constexpr size_t OFF_AMLA = OFF_REST, OFF_QM = OFF_AMLA + (size_t)NT * 384 * 2, OFF_KM = OFF_QM + (size_t)NT * 384 * 2,
                 OFF_CUM = OFF_KM + (size_t)NT * 384 * 2, OFF_ROPE = OFF_CUM + (size_t)NB * 4 * TT * 4, WS_END = OFF_ROPE + (size_t)TT * 32 * 4;
constexpr size_t OFF_MERGED = OFF_REST;
static_assert(WS_END <= (1ull << 30), "workspace");
constexpr size_t OO_YS = 0, OO_VM = OO_YS + (size_t)NT * 1024 * 2, OO_GW = OO_VM + (size_t)NT * 256 * 2,
                 OO_GU = OO_GW + (size_t)NB * 4 * 66 * 4096 * 2, OO_END = OO_GU + (size_t)NB * 4 * 66 * 4096 * 2;
static_assert(OO_END <= (size_t)NB * 4096 * 1024 * 4, "out scratch");

struct KPA { const float* in[31]; char* ws; char* out; int lo, hi; };
struct KP { const KPA* a; int z; char* ws; char* out;
    __device__ __forceinline__ const float* inp(int i) const { return a->in[i + z]; } };

__device__ __forceinline__ unsigned cvt_pk_bf16(float lo, float hi) { unsigned r; asm("v_cvt_pk_bf16_f32 %0, %1, %2" : "=v"(r) : "v"(lo), "v"(hi)); return r; }
__device__ __forceinline__ bf16_t f2bf(float f) { return (bf16_t)(cvt_pk_bf16(f, 0.f) & 0xffffu); }
__device__ __forceinline__ float bf2f(bf16_t b) { return __uint_as_float(((unsigned)b) << 16); }
__device__ __forceinline__ float bflo(unsigned w) { return __uint_as_float(w << 16); }
__device__ __forceinline__ float bfhi(unsigned w) { return __uint_as_float(w & 0xffff0000u); }
__device__ __forceinline__ float sigmoidf_(float x) { return __builtin_amdgcn_rcpf(1.0f + __expf(-x)); }
__device__ __forceinline__ float siluf_(float x) { return x * sigmoidf_(x); }
__device__ __forceinline__ int otid() { int t = threadIdx.x; asm volatile("" : "+v"(t)); return t; }
__device__ __forceinline__ int obid() { int t = blockIdx.x; asm volatile("" : "+s"(t)); return t; }
__device__ __forceinline__ int ogdim() { int t = gridDim.x; asm volatile("" : "+s"(t)); return t; }
__device__ __forceinline__ float wave_sum(float v) {
#pragma unroll
    for (int o = 32; o >= 1; o >>= 1) v += __shfl_xor(v, o);
    return v;
}

namespace pg8 {
constexpr int BM = 256, BK = 64, HALF = 128, HTB = HALF * BK * 2, NXCD = 8, WGM = 8;
__device__ __forceinline__ int lds_byte(int r, int c) { const int st = (r >> 4) * 2 + (c >> 5), rr = r & 15, cc = c & 31, ob = rr * 64 + cc * 2; return st * 1024 + (ob ^ (((ob >> 9) & 1) << 5)); }
__device__ __forceinline__ void stage_rc(int b, int& R, int& C) { const int st = b / 1024, sb = b % 1024, swz = sb ^ (((sb >> 9) & 1) << 5); R = (st >> 1) * 16 + swz / 64; C = (st & 1) * 32 + (swz % 64) / 2; }
__device__ __forceinline__ int perm32(int rho) { const int n = rho >> 4, i = rho & 15; return 8 * (i >> 2) + 4 * n + (i & 3); }

struct Unit { int pm, pn; const char* pa; const char* pb; };
struct Sched {
    int nM, nN, nwg, G, c, mode; const char* A; const char* B; size_t tA, tB;
    __device__ void init(int nM_, int nN_, int G_, int c_, int mode_, const void* A_, int lda, const void* B_, int ldb) {
        nM = nM_; nN = nN_; nwg = nM * nN; G = G_; c = c_; mode = mode_; A = (const char*)A_; B = (const char*)B_; tA = (size_t)BM * lda * 2; tB = (size_t)BM * ldb * 2; }
    __device__ bool next(int i, Unit& u) const {
        const long L = (long)i * G + c; if (L >= nwg) return false;
        int wgid = (int)L; { const int q = nwg / NXCD, r = nwg % NXCD, xcd = wgid % NXCD, off = wgid / NXCD; wgid = (xcd < r ? xcd * (q + 1) : r * (q + 1) + (xcd - r) * q) + off; }
        const int nig = WGM * nN, gid = wgid / nig, fm = gid * WGM, gsz = (nM - fm) < WGM ? (nM - fm) : WGM;
        u.pm = fm + ((wgid % nig) % gsz); u.pn = (wgid % nig) / gsz;
        if (mode == 0) { u.pa = A + (size_t)u.pm * tA; u.pb = B + (size_t)u.pn * tB; }
        else { const int g = u.pn >> 2, q = u.pn & 3; u.pa = A + (size_t)u.pm * tA + (size_t)g * 512; u.pb = B + (size_t)g * (1024ull * 256 * 2) + (size_t)q * tB; }
        return true;
    }
};

template <class Epi>
__device__ __forceinline__ void gemm_phase(LAS unsigned char* lds, int K, int lda, int ldb, const Sched& S, const Epi& E) {
    asm volatile("" : "+s"(K), "+s"(lda), "+s"(ldb));
    const int tid = otid(), wid = __builtin_amdgcn_readfirstlane(tid >> 6), lane = tid & 63, wr = wid >> 2, wc = wid & 3, fr = lane & 15, fq = lane >> 4;
    const int nt = K / BK;
    unsigned voffA[2], voffB[2];
#pragma unroll
    for (int i = 0; i < 2; ++i) { int R, C; stage_rc(tid * 16 + i * 8192, R, C); const int Rb = Epi::PERM ? ((R & ~31) + perm32(R & 31)) : R;
        voffA[i] = (unsigned)(R * lda + C) * 2u; voffB[i] = (unsigned)(Rb * ldb + C) * 2u; }
    const size_t kstep = (size_t)(BK * 2);
    const size_t hA = (size_t)HALF * lda * 2, hB = (size_t)HALF * ldb * 2;
    const unsigned ldsw = (unsigned)wid * 1024u;
    const int aoff = lds_byte(wr * 64 + fr, fq * 8), boff = lds_byte(wc * 32 + fr, fq * 8);
#define PG8_SA(b, h) (((b) * 2 + (h)) * HTB)
#define PG8_SB(b, h) ((4 + (b) * 2 + (h)) * HTB)
#define PG8_STAGE(bufoff, gbase, voff) do { _Pragma("unroll") for (int _i = 0; _i < 2; ++_i) \
        __builtin_amdgcn_global_load_lds((const unsigned*)((const char*)(gbase) + (voff)[_i]), (LAS unsigned*)(lds + (bufoff) + ldsw + _i * 8192), 16, 0, 0); } while (0)
#define PG8_LDA(dst, b, h) do { _Pragma("unroll") for (int m = 0; m < 4; ++m) _Pragma("unroll") for (int k = 0; k < 2; ++k) dst[m][k] = *(const LAS bf16x8*)(lds + PG8_SA(b, h) + aoff + m * 2048 + k * 1024); } while (0)
#define PG8_LDB(dst, b, h) do { _Pragma("unroll") for (int n = 0; n < 2; ++n) _Pragma("unroll") for (int k = 0; k < 2; ++k) dst[n][k] = *(const LAS bf16x8*)(lds + PG8_SB(b, h) + boff + n * 2048 + k * 1024); } while (0)
#define PG8_MMA(ai, bj, At, Bt) do { __builtin_amdgcn_s_setprio(1); _Pragma("unroll") for (int m = 0; m < 4; ++m) _Pragma("unroll") for (int n = 0; n < 2; ++n) _Pragma("unroll") for (int k = 0; k < 2; ++k) \
        acc[ai][bj][m][n] = __builtin_amdgcn_mfma_f32_16x16x32_bf16(Bt[n][k], At[m][k], acc[ai][bj][m][n], 0, 0, 0); __builtin_amdgcn_s_setprio(0); } while (0)
#define PG8_WAIT_V(n) asm volatile("s_waitcnt vmcnt(" #n ")" ::: "memory")
#define PG8_WAIT_L(n) asm volatile("s_waitcnt lgkmcnt(" #n ")" ::: "memory")
#define PG8_BAR __builtin_amdgcn_s_barrier()
#define PG8_SCHED __builtin_amdgcn_sched_barrier(0)
    Unit cur, nxt; int ui = 0;
    if (!S.next(0, cur)) return;
    f32x4 acc[2][2][4][2];
#pragma unroll
    for (int a = 0; a < 2; ++a)
#pragma unroll
        for (int b = 0; b < 2; ++b)
#pragma unroll
            for (int m = 0; m < 4; ++m)
#pragma unroll
                for (int n = 0; n < 2; ++n) acc[a][b][m][n] = (f32x4){0.f, 0.f, 0.f, 0.f};
    bf16x8 At[4][2], B0[2][2], B1[2][2];
    const char* cA = cur.pa; const char* cB = cur.pb;
    PG8_STAGE(PG8_SB(0, 0), cB, voffB); PG8_STAGE(PG8_SA(0, 0), cA, voffA); PG8_STAGE(PG8_SB(0, 1), cB + hB, voffB); PG8_STAGE(PG8_SA(0, 1), cA + hA, voffA);
    if (wr == 1) PG8_BAR;
    PG8_WAIT_V(4); PG8_BAR;
    PG8_STAGE(PG8_SB(1, 0), cB + kstep, voffB); PG8_STAGE(PG8_SA(1, 0), cA + kstep, voffA); PG8_STAGE(PG8_SB(1, 1), cB + hB + kstep, voffB);
    PG8_WAIT_V(6); PG8_BAR;
    for (;;) {
        const bool has_next = S.next(ui + 1, nxt);
        const char* nA = has_next ? nxt.pa : cA; const char* nB = has_next ? nxt.pb : cB;
        for (int t = 0; t < nt; t += 2) {
            const bool last = (t == nt - 2);
            const char* a1 = cA + (size_t)(t + 1) * kstep;
            const char* a2 = last ? nA : cA + (size_t)(t + 2) * kstep; const char* b2 = last ? nB : cB + (size_t)(t + 2) * kstep;
            const char* a3 = a2 + kstep; const char* b3 = b2 + kstep;
            PG8_LDB(B0, 0, 0); PG8_SCHED; PG8_LDA(At, 0, 0); PG8_STAGE(PG8_SA(1, 1), a1 + hA, voffA);
            PG8_WAIT_L(8); PG8_BAR; PG8_WAIT_L(0); PG8_MMA(0, 0, At, B0); PG8_BAR; PG8_SCHED;
            PG8_LDB(B1, 0, 1); PG8_STAGE(PG8_SB(0, 0), b2, voffB);
            PG8_BAR; PG8_WAIT_L(0); PG8_MMA(0, 1, At, B1); PG8_BAR;
            PG8_LDA(At, 0, 1); PG8_STAGE(PG8_SA(0, 0), a2, voffA);
            PG8_BAR; PG8_WAIT_L(0); PG8_MMA(1, 0, At, B0); PG8_BAR; PG8_SCHED;
            PG8_STAGE(PG8_SB(0, 1), b2 + hB, voffB);
            PG8_WAIT_V(6); PG8_BAR; PG8_MMA(1, 1, At, B1); PG8_BAR;
            PG8_LDB(B0, 1, 0); PG8_SCHED; PG8_LDA(At, 1, 0); PG8_STAGE(PG8_SA(0, 1), a2 + hA, voffA);
            PG8_WAIT_L(8); PG8_BAR; PG8_WAIT_L(0); PG8_MMA(0, 0, At, B0); PG8_BAR; PG8_SCHED;
            PG8_LDB(B1, 1, 1); PG8_STAGE(PG8_SB(1, 0), b3, voffB);
            PG8_BAR; PG8_WAIT_L(0); PG8_MMA(0, 1, At, B1); PG8_BAR;
            PG8_LDA(At, 1, 1); PG8_STAGE(PG8_SA(1, 0), a3, voffA);
            PG8_BAR; PG8_WAIT_L(0); PG8_MMA(1, 0, At, B0); PG8_BAR; PG8_SCHED;
            PG8_STAGE(PG8_SB(1, 1), b3 + hB, voffB);
            PG8_WAIT_V(6); PG8_BAR; PG8_MMA(1, 1, At, B1); PG8_BAR;
        }
        E(acc, cur, wr, wc, fr, fq);
        if (!has_next) break;
#pragma unroll
        for (int a = 0; a < 2; ++a)
#pragma unroll
            for (int b = 0; b < 2; ++b)
#pragma unroll
                for (int m = 0; m < 4; ++m)
#pragma unroll
                    for (int n = 0; n < 2; ++n) acc[a][b][m][n] = (f32x4){0.f, 0.f, 0.f, 0.f};
        cur = nxt; cA = nA; cB = nB; ++ui;
    }
    PG8_WAIT_V(0);
    if (wr == 0) PG8_BAR;
    PG8_BAR;
#undef PG8_SA
#undef PG8_SB
#undef PG8_STAGE
#undef PG8_LDA
#undef PG8_LDB
#undef PG8_MMA
#undef PG8_WAIT_V
#undef PG8_WAIT_L
#undef PG8_BAR
#undef PG8_SCHED
}

typedef f32x4 Acc[2][2][4][2];

struct EpiSwiglu {
    static constexpr bool PERM = true;
    bf16_t* O;
    __device__ __forceinline__ void operator()(const Acc& acc, const Unit& u, int wr, int wc, int fr, int fq) const {
        const int row0 = u.pm * BM + wr * 64 + fr, col0 = u.pn * 128 + wc * 32 + 8 * fq;
#pragma unroll
        for (int ai = 0; ai < 2; ++ai)
#pragma unroll
            for (int m = 0; m < 4; ++m) {
                const f32x4 g0 = acc[ai][0][m][0], g1 = acc[ai][0][m][1], u0 = acc[ai][1][m][0], u1 = acc[ai][1][m][1];
                u32x4 w;
                w.x = cvt_pk_bf16(siluf_(g0[0]) * u0[0], siluf_(g0[1]) * u0[1]); w.y = cvt_pk_bf16(siluf_(g0[2]) * u0[2], siluf_(g0[3]) * u0[3]);
                w.z = cvt_pk_bf16(siluf_(g1[0]) * u1[0], siluf_(g1[1]) * u1[1]); w.w = cvt_pk_bf16(siluf_(g1[2]) * u1[2], siluf_(g1[3]) * u1[3]);
                *(u32x4*)(O + (size_t)(row0 + ai * HALF + m * 16) * FF + col0) = w;
            }
    }
};
struct EpiResid {
    static constexpr bool PERM = false;
    float* H; float alpha;
    __device__ __forceinline__ void operator()(const Acc& acc, const Unit& u, int wr, int wc, int fr, int fq) const {
        const int row0 = u.pm * BM + wr * 64 + fr, col0 = u.pn * BM + wc * 32 + 4 * fq;
#pragma unroll
        for (int ai = 0; ai < 2; ++ai)
#pragma unroll
            for (int m = 0; m < 4; ++m) { float* rowp = H + (size_t)(row0 + ai * HALF + m * 16) * DM + col0;
#pragma unroll
                for (int bj = 0; bj < 2; ++bj)
#pragma unroll
                    for (int n = 0; n < 2; ++n) { f32x4 v = *(f32x4*)(rowp + bj * HALF + n * 16); v += acc[ai][bj][m][n] * alpha; *(f32x4*)(rowp + bj * HALF + n * 16) = v; } }
    }
};
struct EpiBf16 {
    static constexpr bool PERM = true;
    bf16_t* O; int ldc; int ymode;
    __device__ __forceinline__ void operator()(const Acc& acc, const Unit& u, int wr, int wc, int fr, int fq) const {
        const int row0 = u.pm * BM + wr * 64 + fr;
        bf16_t* base = O; int colt = u.pn * BM;
        if (ymode) { base += (size_t)(u.pn >> 2) * HR * 1024; colt = (u.pn & 3) * BM; }
        const int col0 = colt + wc * 32 + 8 * fq;
#pragma unroll
        for (int ai = 0; ai < 2; ++ai)
#pragma unroll
            for (int m = 0; m < 4; ++m) { bf16_t* rowp = base + (size_t)(row0 + ai * HALF + m * 16) * ldc + col0;
#pragma unroll
                for (int bj = 0; bj < 2; ++bj) { const f32x4 v0 = acc[ai][bj][m][0], v1 = acc[ai][bj][m][1];
                    u32x4 w; w.x = cvt_pk_bf16(v0[0], v0[1]); w.y = cvt_pk_bf16(v0[2], v0[3]); w.z = cvt_pk_bf16(v1[0], v1[1]); w.w = cvt_pk_bf16(v1[2], v1[3]);
                    *(u32x4*)(rowp + bj * HALF) = w; } }
    }
};
struct EpiMlaUp {
    static constexpr bool PERM = false;
    bf16_t* Qm; bf16_t* Km; bf16_t* Vm;
    __device__ __forceinline__ void operator()(const Acc& acc, const Unit& u, int wr, int wc, int fr, int fq) const {
        const int row0 = u.pm * BM + wr * 64 + fr;
#pragma unroll
        for (int bj = 0; bj < 2; ++bj) {
            const int g32 = u.pn * 8 + bj * 4 + wc;
            if (g32 >= 28) continue;
            if (g32 < 12) {
                {
#pragma unroll
                    for (int ai = 0; ai < 2; ++ai)
#pragma unroll
                        for (int m = 0; m < 4; ++m) { const size_t r = (size_t)(row0 + ai * HALF + m * 16);
#pragma unroll
                            for (int n = 0; n < 2; ++n) { const f32x4 v = acc[ai][bj][m][n]; u32x2 w; w.x = cvt_pk_bf16(v[0], v[1]); w.y = cvt_pk_bf16(v[2], v[3]);
                                *(u32x2*)(Qm + r * 384 + g32 * 32 + n * 16 + 4 * fq) = w; } }
                }
            } else {
                const int cc = (g32 - 12) * 32, hh = cc >> 7, w_ = cc & 127;
                bf16_t* dst; int ld;
                if (w_ < 64) { dst = Km + hh * 96 + w_; ld = 384; } else { dst = Vm + hh * 64 + (w_ - 64); ld = 256; }
#pragma unroll
                for (int ai = 0; ai < 2; ++ai)
#pragma unroll
                    for (int m = 0; m < 4; ++m) { const size_t r = (size_t)(row0 + ai * HALF + m * 16);
#pragma unroll
                        for (int n = 0; n < 2; ++n) { const f32x4 v = acc[ai][bj][m][n]; u32x2 w; w.x = cvt_pk_bf16(v[0], v[1]); w.y = cvt_pk_bf16(v[2], v[3]);
                            *(u32x2*)(dst + r * ld + n * 16 + 4 * fq) = w; } }
            }
        }
    }
};
struct EpiGate {
    static constexpr bool PERM = false;
    bf16_t* Mg; const bf16_t* Y; const float* bg; int rowoff;
    __device__ __forceinline__ void operator()(const Acc& acc, const Unit& u, int wr, int wc, int fr, int fq) const {
        const int row0 = u.pm * BM + wr * 64 + fr, colr = u.pn * 64 + wc * 16 + 4 * fq;
        f32x4 bv[4];
#pragma unroll
        for (int g = 0; g < 4; ++g) bv[g] = *(const f32x4*)(bg + g * 1024 + colr);
#pragma unroll
        for (int ai = 0; ai < 2; ++ai)
#pragma unroll
            for (int m = 0; m < 4; ++m) { const int rl = row0 + ai * HALF + m * 16;
                f32x4 s = (f32x4){0.f, 0.f, 0.f, 0.f};
#pragma unroll
                for (int bj = 0; bj < 2; ++bj)
#pragma unroll
                    for (int n = 0; n < 2; ++n) { const int g = 2 * bj + n; const f32x4 a = acc[ai][bj][m][n] + bv[g];
                        const u32x2 y = *(const u32x2*)(Y + ((size_t)g * HR + rl) * 1024 + colr);
                        s[0] += sigmoidf_(a[0]) * bflo(y.x); s[1] += sigmoidf_(a[1]) * bfhi(y.x); s[2] += sigmoidf_(a[2]) * bflo(y.y); s[3] += sigmoidf_(a[3]) * bfhi(y.y); }
                u32x2 w; w.x = cvt_pk_bf16(s[0], s[1]); w.y = cvt_pk_bf16(s[2], s[3]);
                *(u32x2*)(Mg + (size_t)(rowoff + rl) * 1024 + colr) = w; }
    }
};
}

__device__ __forceinline__ int win_map(int m) {
    if (m < 768) return m;
    if (m < 1888) return m + 4;
    if (m < 2400) return m + 12;
    if (m < 2404) return m - 1632;
    if (m < 2412) return m - 512;
    return -1;
}
__device__ __forceinline__ float wfetch(const KP& p, int l, int job, int n, int k) {
    switch (job) {
    case 0: case 2: { const int pn = n >> 8, bj = (n >> 7) & 1, c = n & 127; const float* s = p.inp(job == 0 ? 3 : 28) + (size_t)l * 1024 * 5632; return s[(size_t)k * 5632 + bj * FF + pn * 128 + c]; }
    case 1: case 3: { const float* s = p.inp(job == 1 ? 4 : 29) + (size_t)l * FF * 1024; return s[(size_t)k * 1024 + n]; }
    case 4: { const int o = win_map(n); return o < 0 ? 0.f : p.inp(6)[(size_t)l * 1024 * 2412 + (size_t)k * 2412 + o]; }
    case 5: { const int pn = n >> 8, bj = (n >> 7) & 1, wc = (n >> 5) & 3, nn = (n >> 4) & 1, fq = (n >> 2) & 3, j = n & 3; const int g = 2 * bj + nn, col = 64 * pn + 16 * wc + 4 * fq + j;
              return p.inp(23)[((size_t)(l * 4 + g) * 1024 + k) * 1024 + col]; }
    case 6: { const int g = n >> 10, col = n & 1023; return p.inp(25)[((size_t)(l * 4 + g) * 256 + k) * 1024 + col]; }
    case 7: return p.inp(26)[(size_t)l * 1024 * 1024 + (size_t)k * 1024 + n];
    default: {
        if (n < 384) return k < 192 ? p.inp(9)[(size_t)l * 192 * 384 + (size_t)k * 384 + n] : 0.f;
        if (n < 896) return (k >= 192 && k < 320) ? p.inp(11)[(size_t)l * 128 * 512 + (size_t)(k - 192) * 512 + (n - 384)] : 0.f;
        return 0.f; }
    }
}
__device__ void phase_prep(const KP& p, LAS unsigned char* lds) {
    const int tid = otid();
    LAS float* tile = (LAS float*)lds;
    const int jNp[9] = {5632, 1024, 5632, 1024, 2560, 4096, 4096, 1024, 1024};
    const int jKp[9] = {1024, 2816, 1024, 2816, 1024, 1024, 256, 1024, 384};
    const size_t jOff[9] = {W_WI1, W_WO1, W_WI2, W_WO2, W_WIN, W_WG, W_WB, W_WOUT, W_WUP};
    int total = 0;
#pragma unroll
    for (int j = 0; j < 9; ++j) total += (jNp[j] / 64) * (jKp[j] / 64);
    for (int it = obid(); it < 2 * total; it += ogdim()) {
        const int l = it / total; int rr = it % total; int job = 0, Kp = jKp[0]; size_t off = jOff[0]; bool found = false;
#pragma unroll
        for (int j = 0; j < 9; ++j) { const int cnt = (jNp[j] / 64) * (jKp[j] / 64);
            if (!found) { if (rr < cnt) { job = j; Kp = jKp[j]; off = jOff[j]; found = true; } else rr -= cnt; } }
        const int nkt = Kp / 64; const int n0 = (rr / nkt) * 64, k0 = (rr % nkt) * 64;
        const int nn = tid & 63, kk0 = tid >> 6;
#pragma unroll
        for (int i = 0; i < 8; ++i) { const int kk = kk0 + 8 * i; tile[kk * 65 + nn] = wfetch(p, l, job, n0 + nn, k0 + kk); }
        __syncthreads();
        { const int n2 = tid >> 3, kg = tid & 7; float v[8];
#pragma unroll
          for (int e = 0; e < 8; ++e) v[e] = tile[(kg * 8 + e) * 65 + n2];
          u32x4 w; w.x = cvt_pk_bf16(v[0], v[1]); w.y = cvt_pk_bf16(v[2], v[3]); w.z = cvt_pk_bf16(v[4], v[5]); w.w = cvt_pk_bf16(v[6], v[7]);
          bf16_t* dst = (bf16_t*)(p.ws + OFF_W + (size_t)l * W_LAYER + off);
          *(u32x4*)(dst + (size_t)(n0 + n2) * Kp + k0 + kg * 8) = w; }
        __syncthreads();
    }
    float* rope = (float*)(p.ws + OFF_ROPE);
    for (int i = obid() * NTHR + tid; i < TT * 16; i += ogdim() * NTHR) {
        const int t = i >> 4, f = i & 15;
        const float inv = powf(10000.0f, -(float)f * (1.0f / 16.0f));
        const float ang = (float)(t - PADL) * inv;
        rope[i] = cosf(ang); rope[TT * 16 + i] = sinf(ang);
    }
}

__device__ void phase_rmsnorm(const KP& p, const float* g, int mode) {
    const int tid = otid(), wid = tid >> 6, lane = tid & 63;
    float* H = (float*)(p.ws + OFF_H); bf16_t* UN = (bf16_t*)(p.ws + OFF_UN);
    f32x4 gv[4];
#pragma unroll
    for (int i = 0; i < 4; ++i) gv[i] = *(const f32x4*)(g + i * 256 + lane * 4);
    for (int row = obid() * 8 + wid; row < NT; row += ogdim() * 8) {
        const int b = row / TT, t = row % TT;
        if (mode == 3 && t < 128) continue;
        f32x4 v[4];
        if (mode == 2) {
            const float* src = t < PADL ? nullptr : (t < 128 ? p.inp(1) + (size_t)(t - PADL) * DM : p.inp(0) + ((size_t)b * 4096 + (t - 128)) * DM);
#pragma unroll
            for (int i = 0; i < 4; ++i) { v[i] = src ? *(const f32x4*)(src + i * 256 + lane * 4) : (f32x4){0.f, 0.f, 0.f, 0.f}; *(f32x4*)(H + (size_t)row * DM + i * 256 + lane * 4) = v[i]; }
        } else {
#pragma unroll
            for (int i = 0; i < 4; ++i) v[i] = *(const f32x4*)(H + (size_t)row * DM + i * 256 + lane * 4);
        }
        float ss = 0.f;
#pragma unroll
        for (int i = 0; i < 4; ++i) ss += v[i][0] * v[i][0] + v[i][1] * v[i][1] + v[i][2] * v[i][2] + v[i][3] * v[i][3];
        ss = wave_sum(ss);
        float rstd = rsqrtf(ss * (1.0f / DM) + EPS);
        if (mode == 1 && t < PADL) rstd = 0.f;
        if (mode == 3) {
            float* o = (float*)p.out + ((size_t)b * 4096 + (t - 128)) * DM;
#pragma unroll
            for (int i = 0; i < 4; ++i) *(f32x4*)(o + i * 256 + lane * 4) = v[i] * rstd * gv[i];
        } else {
#pragma unroll
            for (int i = 0; i < 4; ++i) { const f32x4 y = v[i] * rstd * gv[i]; u32x2 w; w.x = cvt_pk_bf16(y[0], y[1]); w.y = cvt_pk_bf16(y[2], y[3]);
                *(u32x2*)(UN + (size_t)row * DM + i * 256 + lane * 4) = w; }
        }
    }
}

__device__ void phase_mla_pre(const KP& p, int l) {
    const int tid = otid(), wid = tid >> 6, lane = tid & 63;
    const bf16_t* P = (const bf16_t*)(p.ws + OFF_BIG); bf16_t* A = (bf16_t*)(p.ws + OFF_AMLA); bf16_t* Km = (bf16_t*)(p.ws + OFF_KM);
    const float* rope = (const float*)(p.ws + OFF_ROPE);
    const float* gq = p.inp(8) + l * 192; const float* gkv = p.inp(10) + l * 128;
    const float gq0 = gq[lane], gq1 = gq[lane + 64], gq2 = gq[lane + 128], gk0 = gkv[lane], gk1 = gkv[lane + 64];
    for (int row = obid() * 8 + wid; row < NT; row += ogdim() * 8) {
        const bf16_t* pr = P + (size_t)row * PN; const int t = row % TT;
        const float c0 = bf2f(pr[PC_CQ + lane]), c1 = bf2f(pr[PC_CQ + 64 + lane]), c2 = bf2f(pr[PC_CQ + 128 + lane]);
        const float k0 = bf2f(pr[PC_CKV + lane]), k1 = bf2f(pr[PC_CKV + 64 + lane]);
        const float sq = wave_sum(c0 * c0 + c1 * c1 + c2 * c2), sk = wave_sum(k0 * k0 + k1 * k1);
        const float rq = rsqrtf(sq * (1.0f / 192.0f) + EPS), rk = rsqrtf(sk * (1.0f / 128.0f) + EPS);
        bf16_t* ar = A + (size_t)row * 384;
        ar[lane] = f2bf(c0 * rq * gq0); ar[lane + 64] = f2bf(c1 * rq * gq1); ar[lane + 128] = f2bf(c2 * rq * gq2);
        ar[192 + lane] = f2bf(k0 * rk * gk0); ar[256 + lane] = f2bf(k1 * rk * gk1); ar[320 + lane] = 0;
        if (lane < 16) {
            const float x1 = bf2f(pr[PC_KR + lane]), x2 = bf2f(pr[PC_KR + 16 + lane]);
            const float cs = rope[t * 16 + lane], sn = rope[TT * 16 + t * 16 + lane];
            const bf16_t o1 = f2bf(x1 * cs - x2 * sn), o2 = f2bf(x2 * cs + x1 * sn);
            bf16_t* kr = Km + (size_t)row * 384;
#pragma unroll
            for (int hh = 0; hh < 4; ++hh) { kr[hh * 96 + 64 + lane] = o1; kr[hh * 96 + 80 + lane] = o2; }
        }
    }
}
__device__ void phase_fox_cum(const KP& p, int l) {
    const int tid = otid(), wid = tid >> 6, lane = tid & 63;
    const int gw = obid() * 8 + wid;
    if (gw >= NB * 4) return;
    const int b = gw >> 2, h = gw & 3;
    const bf16_t* P = (const bf16_t*)(p.ws + OFF_BIG); float* cum = (float*)(p.ws + OFF_CUM) + (size_t)gw * TT;
    const float bf = p.inp(7)[l * 4 + h];
    float carry = 0.f;
    for (int t0 = 0; t0 < TT; t0 += 64) {
        const int t = t0 + lane;
        float v = 0.f;
        if (t >= PADL) { const float x = bf2f(P[((size_t)b * TT + t) * PN + PC_FF + h]) + bf; v = fminf(x, 0.f) - log1pf(expf(-fabsf(x))); }
#pragma unroll
        for (int o = 1; o < 64; o <<= 1) { const float u = __shfl_up(v, o); if (lane >= o) v += u; }
        v += carry;
        cum[t] = v * LOG2E;
        carry = __shfl(v, 63);
    }
}

__device__ void lru_item(const KP& p, int l, LAS unsigned char* lds, int item) {
    const int tid = otid(), j = tid & 63, tq = tid >> 6;
    const int b = item >> 2, n = item & 3, c = n * 64 + j;
    const bf16_t* P = (const bf16_t*)(p.ws + OFF_BIG) + (size_t)b * TT * PN + PC_LRU + c;
    bf16_t* YS = (bf16_t*)(p.out + OO_YS) + (size_t)b * TT * 1024 + 768 + c;
    LAS float* xs = (LAS float*)lds;
    LAS float* as = xs + 4096;
    LAS float* bs = as + 4096;
    LAS float* wa = bs + 4096;
    LAS float* wx = wa + 4096;
    const float* cw = p.inp(16) + (size_t)l * 4 * 256;
    const float w0 = cw[c], w1 = cw[256 + c], w2 = cw[512 + c], w3 = cw[768 + c], cb = p.inp(17)[l * 256 + c];
    const float ba = p.inp(19)[l * 256 + c], bx = p.inp(21)[l * 256 + c];
    const float lam = p.inp(22)[l * 256 + c]; const float sp = log1pf(expf(-lam));
    __syncthreads();
    { const float* WA = p.inp(18) + ((size_t)(l * 4 + n)) * 4096; const float* WX = p.inp(20) + ((size_t)(l * 4 + n)) * 4096;
#pragma unroll
      for (int i = 0; i < 8; ++i) { wa[tid + i * 512] = WA[tid + i * 512]; wx[tid + i * 512] = WX[tid + i * 512]; } }
    for (int e = tid; e < 64 * 64; e += NTHR) (YS - j)[(size_t)(e >> 6) * 1024 + (e & 63)] = 0;
    float hst = 0.f;
    for (int t0 = 64; t0 < TT; t0 += 64) {
        {
            const int tb = t0 + tq * 8;
            float x0 = bf2f(P[(size_t)(tb - 3) * PN]), x1 = bf2f(P[(size_t)(tb - 2) * PN]), x2 = bf2f(P[(size_t)(tb - 1) * PN]);
#pragma unroll
            for (int e = 0; e < 8; ++e) { const float x3 = bf2f(P[(size_t)(tb + e) * PN]);
                float xr = cb + w0 * x0 + w1 * x1 + w2 * x2 + w3 * x3; if (tb + e < PADL) xr = 0.f;
                xs[(tq * 8 + e) * 64 + j] = xr; x0 = x1; x1 = x2; x2 = x3; }
        }
        __syncthreads();
        {
            float aa[8], ax[8];
#pragma unroll
            for (int e = 0; e < 8; ++e) { aa[e] = 0.f; ax[e] = 0.f; }
            for (int i4 = 0; i4 < 16; ++i4) {
                float wav[4], wxv[4];
#pragma unroll
                for (int q = 0; q < 4; ++q) { wav[q] = wa[(i4 * 4 + q) * 64 + j]; wxv[q] = wx[(i4 * 4 + q) * 64 + j]; }
#pragma unroll
                for (int e = 0; e < 8; ++e) { const f32x4 x = *(const LAS f32x4*)(xs + (tq * 8 + e) * 64 + i4 * 4);
                    aa[e] += x[0] * wav[0] + x[1] * wav[1] + x[2] * wav[2] + x[3] * wav[3]; ax[e] += x[0] * wxv[0] + x[1] * wxv[1] + x[2] * wxv[2] + x[3] * wxv[3]; }
            }
#pragma unroll
            for (int e = 0; e < 8; ++e) {
                const float r = 1.0f / (1.0f + expf(-(aa[e] + ba))), ig = 1.0f / (1.0f + expf(-(ax[e] + bx)));
                const float la = -8.0f * r * sp; const float a = expf(la);
                const float bb = sqrtf(-expm1f(2.0f * la)) * ig * xs[(tq * 8 + e) * 64 + j];
                as[(tq * 8 + e) * 64 + j] = a; bs[(tq * 8 + e) * 64 + j] = bb;
            }
        }
        __syncthreads();
        if (tq == 0) {
            for (int t = 0; t < 64; ++t) { hst = as[t * 64 + j] * hst + bs[t * 64 + j]; YS[(size_t)(t0 + t) * 1024] = f2bf(hst); }
        }
    }
    __syncthreads();
}

constexpr int GS = 72;
template <bool SWAP>
__device__ __forceinline__ f32x4 mma_nt(const LAS bf16_t* A, const LAS bf16_t* B, int ti, int tj, int lane, f32x4 acc) {
    const int fr = lane & 15, fq = lane >> 4;
#pragma unroll
    for (int ks = 0; ks < 2; ++ks) {
        const bf16x8 a = *(const LAS bf16x8*)(A + (ti * 16 + fr) * GS + ks * 32 + fq * 8);
        const bf16x8 b = *(const LAS bf16x8*)(B + (tj * 16 + fr) * GS + ks * 32 + fq * 8);
        acc = SWAP ? __builtin_amdgcn_mfma_f32_16x16x32_bf16(b, a, acc, 0, 0, 0) : __builtin_amdgcn_mfma_f32_16x16x32_bf16(a, b, acc, 0, 0, 0);
    }
    return acc;
}
__device__ __forceinline__ void gdn_conv_tile(const bf16_t* Pc  , const float* cw  , int t0, LAS float* dst) {
    const int tid = otid(), ch = tid & 63, tq = tid >> 6;
    const float w0 = cw[ch], w1 = cw[768 + ch], w2 = cw[1536 + ch], w3 = cw[2304 + ch];
    const int tb = t0 + tq * 8; const bf16_t* P = Pc + ch;
    float x0 = bf2f(P[(size_t)(tb - 3) * PN]), x1 = bf2f(P[(size_t)(tb - 2) * PN]), x2 = bf2f(P[(size_t)(tb - 1) * PN]);
#pragma unroll
    for (int e = 0; e < 8; ++e) { const float x3 = bf2f(P[(size_t)(tb + e) * PN]);
        dst[(tq * 8 + e) * 64 + ch] = siluf_(w0 * x0 + w1 * x1 + w2 * x2 + w3 * x3); x0 = x1; x1 = x2; x2 = x3; }
}
__device__ __forceinline__ void gdn_gates(const KP& p, int l, int b, int h, int t0, LAS float* betas, LAS float* Gs) {
    const int lane = otid() & 63;
    const bf16_t* pr = (const bf16_t*)(p.ws + OFF_BIG) + ((size_t)b * TT + t0 + lane) * PN;
    const float araw = bf2f(pr[PC_GA + h]), braw = bf2f(pr[PC_GB + h]);
    const float A = expf(p.inp(13)[l * 4 + h]), dtb = p.inp(14)[l * 4 + h];
    const float z = araw + dtb; const float spz = fmaxf(z, 0.f) + log1pf(expf(-fabsf(z)));
    float g = -A * spz;
#pragma unroll
    for (int o = 1; o < 64; o <<= 1) { const float u = __shfl_up(g, o); if (lane >= o) g += u; }
    betas[lane] = 1.0f / (1.0f + expf(-braw)); Gs[lane] = g;
}

__device__ void gdn_pre_chunk(const KP& p, int l, LAS unsigned char* lds, int cid) {
    const int tid = otid(), wid = tid >> 6, lane = tid & 63;
    const int n = cid % 66, bh = cid / 66, b = bh >> 2, h = bh & 3, t0 = n * 64;
    bf16_t* GW = (bf16_t*)(p.out + OO_GW) + (size_t)cid * 4096; bf16_t* GU = (bf16_t*)(p.out + OO_GU) + (size_t)cid * 4096;
    if (n == 0) return;
    LAS float* Kf = (LAS float*)lds;
    LAS float* Vf = Kf + 4096;
    LAS float* Mm = Vf + 4096;
    LAS float* betas = Mm + 4096; LAS float* Gs = betas + 64;
    LAS bf16_t* Kc = (LAS bf16_t*)(Gs + 64);
    const bf16_t* Pb = (const bf16_t*)(p.ws + OFF_BIG) + (size_t)b * TT * PN;
    const float* cw = p.inp(12) + (size_t)l * 4 * 768;
    __syncthreads();
    gdn_conv_tile(Pb + PC_GK + h * 64, cw + 256 + h * 64, t0, Kf);
    gdn_conv_tile(Pb + PC_GV + h * 64, cw + 512 + h * 64, t0, Vf);
    if (wid == 0) gdn_gates(p, l, b, h, t0, betas, Gs);
    __syncthreads();
    {
        const int row = tid >> 3, seg = tid & 7; float v[8]; float ss = 0.f;
#pragma unroll
        for (int e = 0; e < 8; ++e) { v[e] = Kf[row * 64 + seg * 8 + e]; ss += v[e] * v[e]; }
        ss += __shfl_xor(ss, 1); ss += __shfl_xor(ss, 2); ss += __shfl_xor(ss, 4);
        const float rs = rsqrtf(ss + EPS);
#pragma unroll
        for (int e = 0; e < 8; ++e) { v[e] *= rs; Kf[row * 64 + seg * 8 + e] = v[e]; }
        u32x4 w; w.x = cvt_pk_bf16(v[0], v[1]); w.y = cvt_pk_bf16(v[2], v[3]); w.z = cvt_pk_bf16(v[4], v[5]); w.w = cvt_pk_bf16(v[6], v[7]);
        *(LAS u32x4*)(Kc + row * GS + seg * 8) = w;
    }
    __syncthreads();
    {
        const int fr = lane & 15, fq = lane >> 4;
#pragma unroll
        for (int q = 0; q < 2; ++q) { const int tile = wid * 2 + q, ti = tile >> 2, tj = tile & 3;
            const f32x4 d = mma_nt<false>(Kc, Kc, ti, tj, lane, (f32x4){0.f, 0.f, 0.f, 0.f});
            const int i = tj * 16 + fr, j0 = ti * 16 + 4 * fq; const float bi = betas[i], gi = Gs[i];
            f32x4 o;
#pragma unroll
            for (int e = 0; e < 4; ++e) { const int jj = j0 + e; o[e] = (i > jj) ? bi * d[e] * expf(gi - Gs[jj]) : 0.f; }
            *(LAS f32x4*)(Mm + i * 64 + j0) = o; }
    }
    __syncthreads();
    if (tid < 128) {
        const int col = tid & 63; const bool isw = tid < 64;
        float s[64];
#pragma unroll
        for (int i = 0; i < 64; ++i) {
            const float bi = betas[i];
            float r = isw ? Kf[i * 64 + col] * bi * expf(Gs[i]) : Vf[i * 64 + col] * bi;
#pragma unroll
            for (int j4 = 0; j4 < (i + 3) / 4; ++j4) { const f32x4 mv = *(const LAS f32x4*)(Mm + i * 64 + j4 * 4);
#pragma unroll
                for (int e = 0; e < 4; ++e) if (j4 * 4 + e < i) r -= mv[e] * s[j4 * 4 + e]; }
            s[i] = r;
            if (isw) GW[i * 64 + col] = f2bf(r);
        }
        if (!isw) {
#pragma unroll
            for (int q = 0; q < 8; ++q) { u32x4 w; w.x = cvt_pk_bf16(s[q * 8], s[q * 8 + 1]); w.y = cvt_pk_bf16(s[q * 8 + 2], s[q * 8 + 3]); w.z = cvt_pk_bf16(s[q * 8 + 4], s[q * 8 + 5]); w.w = cvt_pk_bf16(s[q * 8 + 6], s[q * 8 + 7]);
                *(u32x4*)(GU + col * 64 + q * 8) = w; }
        }
    }
}

__device__ void gdn_scan_item(const KP& p, int l, LAS unsigned char* lds, int bh) {
    const int tid = otid(), wid = tid >> 6, lane = tid & 63, fr = lane & 15, fq = lane >> 4;
    const int b = bh >> 2, h = bh & 3;
    LAS float* Qf = (LAS float*)lds;
    LAS float* Kf = Qf + 4096;
    LAS float* betas = Kf + 4096; LAS float* Gs = betas + 64;
    LAS bf16_t* Qc = (LAS bf16_t*)(Gs + 64);
    LAS bf16_t* Kc = Qc + 64 * GS; LAS bf16_t* QD = Kc + 64 * GS; LAS bf16_t* KDT = QD + 64 * GS; LAS bf16_t* QK = KDT + 64 * GS;
    LAS bf16_t* Wc = QK + 64 * GS; LAS bf16_t* ST = Wc + 64 * GS; LAS bf16_t* VNT = ST + 64 * GS; LAS bf16_t* UT = VNT + 64 * GS;
    const bf16_t* Pb = (const bf16_t*)(p.ws + OFF_BIG) + (size_t)b * TT * PN;
    const float* cw = p.inp(12) + (size_t)l * 4 * 768;
    bf16_t* YS = (bf16_t*)(p.out + OO_YS) + (size_t)b * TT * 1024 + 512 + h * 64;
    const float* gon = p.inp(15) + l * 64;
    __syncthreads();
    for (int e = tid; e < 64 * GS / 2; e += NTHR) ((LAS unsigned*)ST)[e] = 0u;
    for (int e = tid; e < 64 * 16; e += NTHR) *(u32x2*)(YS + (size_t)(e >> 4) * 1024 + (e & 15) * 4) = (u32x2){0u, 0u};
    f32x4 Sacc[2] = {(f32x4){0.f, 0.f, 0.f, 0.f}, (f32x4){0.f, 0.f, 0.f, 0.f}};
    for (int n = 1; n < 66; ++n) {
        const int t0 = n * 64; const size_t cid = (size_t)bh * 66 + n;
        gdn_conv_tile(Pb + PC_GQ + h * 64, cw + h * 64, t0, Qf);
        gdn_conv_tile(Pb + PC_GK + h * 64, cw + 256 + h * 64, t0, Kf);
        if (wid == 0) gdn_gates(p, l, b, h, t0, betas, Gs);
        { const int row = tid >> 3, seg = tid & 7;
          const u32x4 w = *(const u32x4*)((const bf16_t*)(p.out + OO_GW) + cid * 4096 + row * 64 + seg * 8);
          const u32x4 u = *(const u32x4*)((const bf16_t*)(p.out + OO_GU) + cid * 4096 + row * 64 + seg * 8);
          *(LAS u32x4*)(Wc + row * GS + seg * 8) = w; *(LAS u32x4*)(UT + row * GS + seg * 8) = u; }
        __syncthreads();
        {
            const int row = tid >> 3, seg = tid & 7; float q[8], k[8]; float sq = 0.f, sk = 0.f;
#pragma unroll
            for (int e = 0; e < 8; ++e) { q[e] = Qf[row * 64 + seg * 8 + e]; k[e] = Kf[row * 64 + seg * 8 + e]; sq += q[e] * q[e]; sk += k[e] * k[e]; }
            sq += __shfl_xor(sq, 1); sq += __shfl_xor(sq, 2); sq += __shfl_xor(sq, 4);
            sk += __shfl_xor(sk, 1); sk += __shfl_xor(sk, 2); sk += __shfl_xor(sk, 4);
            const float rq = rsqrtf(sq + EPS) * 0.125f, rk = rsqrtf(sk + EPS);
            const float g = Gs[row], eg = expf(g), ekd = expf(Gs[63] - g);
#pragma unroll
            for (int e = 0; e < 8; ++e) { q[e] *= rq; k[e] *= rk; }
            u32x4 w; w.x = cvt_pk_bf16(q[0], q[1]); w.y = cvt_pk_bf16(q[2], q[3]); w.z = cvt_pk_bf16(q[4], q[5]); w.w = cvt_pk_bf16(q[6], q[7]);
            *(LAS u32x4*)(Qc + row * GS + seg * 8) = w;
            w.x = cvt_pk_bf16(q[0] * eg, q[1] * eg); w.y = cvt_pk_bf16(q[2] * eg, q[3] * eg); w.z = cvt_pk_bf16(q[4] * eg, q[5] * eg); w.w = cvt_pk_bf16(q[6] * eg, q[7] * eg);
            *(LAS u32x4*)(QD + row * GS + seg * 8) = w;
            w.x = cvt_pk_bf16(k[0], k[1]); w.y = cvt_pk_bf16(k[2], k[3]); w.z = cvt_pk_bf16(k[4], k[5]); w.w = cvt_pk_bf16(k[6], k[7]);
            *(LAS u32x4*)(Kc + row * GS + seg * 8) = w;
#pragma unroll
            for (int e = 0; e < 8; ++e) KDT[(seg * 8 + e) * GS + row] = f2bf(k[e] * ekd);
        }
        __syncthreads();
        {
#pragma unroll
            for (int q = 0; q < 2; ++q) { const int tile = wid * 2 + q, ti = tile >> 2, tj = tile & 3;
                const f32x4 d = mma_nt<true>(Qc, Kc, ti, tj, lane, (f32x4){0.f, 0.f, 0.f, 0.f});
                const int i = ti * 16 + fr, j0 = tj * 16 + 4 * fq; const float gi = Gs[i];
                float o[4];
#pragma unroll
                for (int e = 0; e < 4; ++e) { const int jj = j0 + e; o[e] = (i >= jj) ? d[e] * expf(gi - Gs[jj]) : 0.f; }
                u32x2 w; w.x = cvt_pk_bf16(o[0], o[1]); w.y = cvt_pk_bf16(o[2], o[3]);
                *(LAS u32x2*)(QK + i * GS + j0) = w; }
#pragma unroll
            for (int q = 0; q < 2; ++q) { const int tile = wid * 2 + q, ti = tile >> 2, tj = tile & 3;
                const f32x4 d = mma_nt<false>(Wc, ST, ti, tj, lane, (f32x4){0.f, 0.f, 0.f, 0.f});
                const int dv = tj * 16 + fr, c0 = ti * 16 + 4 * fq;
                const u32x2 uu = *(const LAS u32x2*)(UT + dv * GS + c0);
                u32x2 w; w.x = cvt_pk_bf16(bflo(uu.x) - d[0], bfhi(uu.x) - d[1]); w.y = cvt_pk_bf16(bflo(uu.y) - d[2], bfhi(uu.y) - d[3]);
                *(LAS u32x2*)(VNT + dv * GS + c0) = w; }
        }
        __syncthreads();
        {
            const float gl = expf(Gs[63]);
            if (wid < 4) {
                f32x4 o[4];
#pragma unroll
                for (int tv = 0; tv < 4; ++tv) { o[tv] = mma_nt<true>(QD, ST, wid, tv, lane, (f32x4){0.f, 0.f, 0.f, 0.f}); o[tv] = mma_nt<true>(QK, VNT, wid, tv, lane, o[tv]); }
                float ss = 0.f;
#pragma unroll
                for (int tv = 0; tv < 4; ++tv) ss += o[tv][0] * o[tv][0] + o[tv][1] * o[tv][1] + o[tv][2] * o[tv][2] + o[tv][3] * o[tv][3];
                ss += __shfl_xor(ss, 16); ss += __shfl_xor(ss, 32);
                const float rs = rsqrtf(ss * (1.0f / 64.0f) + EPS);
                const int t = t0 + wid * 16 + fr;
                const bf16_t* gp = Pb + (size_t)t * PN + PC_GG + h * 64;
#pragma unroll
                for (int tv = 0; tv < 4; ++tv) { const int dv = tv * 16 + 4 * fq;
                    const u32x2 gg = *(const u32x2*)(gp + dv); const f32x4 gn = *(const f32x4*)(gon + dv);
                    u32x2 w; w.x = cvt_pk_bf16(o[tv][0] * rs * gn[0] * siluf_(bflo(gg.x)), o[tv][1] * rs * gn[1] * siluf_(bfhi(gg.x)));
                    w.y = cvt_pk_bf16(o[tv][2] * rs * gn[2] * siluf_(bflo(gg.y)), o[tv][3] * rs * gn[3] * siluf_(bfhi(gg.y)));
                    if (t < PADL) { w.x = 0u; w.y = 0u; }
                    *(u32x2*)(YS + (size_t)t * 1024 + dv) = w; }
            }
#pragma unroll
            for (int q = 0; q < 2; ++q) { const int tile = wid * 2 + q, ti = tile >> 2, tj = tile & 3;
                Sacc[q] = mma_nt<false>(KDT, VNT, ti, tj, lane, Sacc[q] * gl); }
        }
        __syncthreads();
#pragma unroll
        for (int q = 0; q < 2; ++q) { const int tile = wid * 2 + q, ti = tile >> 2, tj = tile & 3;
            u32x2 w; w.x = cvt_pk_bf16(Sacc[q][0], Sacc[q][1]); w.y = cvt_pk_bf16(Sacc[q][2], Sacc[q][3]);
            *(LAS u32x2*)(ST + (tj * 16 + fr) * GS + ti * 16 + 4 * fq) = w; }
    }
    __syncthreads();
}

template <int DK, bool FOX>
__device__ void attn_item(LAS unsigned char* lds, const bf16_t* Qp, int ldq, const bf16_t* Kp, int ldk, const bf16_t* Vp, int ldv,
                          const float* cum2, const float* rope, float c1, bf16_t* Op, int qt) {
    constexpr int KST = DK + 8, NDS = DK / 16, KPIECES = 64 * DK / 8;
    const int tid = otid(), wid = tid >> 6, lane = tid & 63, qi = lane & 31, half = lane >> 5;
    LAS bf16_t* Ks = (LAS bf16_t*)lds;
    LAS bf16_t* Vt = Ks + 64 * KST;
    LAS float* Cs = (LAS float*)(Vt + 64 * 72);
    const int q0 = qt * 256 + wid * 32, tq = q0 + qi;
    const bool wact = q0 < TT;
    bf16x8 qf[NDS];
#pragma unroll
    for (int ds = 0; ds < NDS; ++ds) qf[ds] = (tq < TT) ? *(const bf16x8*)(Qp + (size_t)tq * ldq + ds * 16 + 8 * half) : (bf16x8){0, 0, 0, 0, 0, 0, 0, 0};
    if (!FOX) {
        const int tr = tq < TT ? tq : TT - 1;
        const float* cs = rope + tr * 16 + 8 * half; const float* sn = rope + TT * 16 + tr * 16 + 8 * half;
        u32x4 a = *(u32x4*)&qf[NDS - 2], b = *(u32x4*)&qf[NDS - 1];
        unsigned aw[4] = {a.x, a.y, a.z, a.w}, bw[4] = {b.x, b.y, b.z, b.w};
#pragma unroll
        for (int e = 0; e < 4; ++e) { const float c0 = cs[2 * e], c1_ = cs[2 * e + 1], s0_ = sn[2 * e], s1_ = sn[2 * e + 1];
            const float x1l = bflo(aw[e]), x1h = bfhi(aw[e]), x2l = bflo(bw[e]), x2h = bfhi(bw[e]);
            aw[e] = cvt_pk_bf16(x1l * c0 - x2l * s0_, x1h * c1_ - x2h * s1_); bw[e] = cvt_pk_bf16(x2l * c0 + x1l * s0_, x2h * c1_ + x1h * s1_); }
        a = (u32x4){aw[0], aw[1], aw[2], aw[3]}; b = (u32x4){bw[0], bw[1], bw[2], bw[3]};
        qf[NDS - 2] = *(bf16x8*)&a; qf[NDS - 1] = *(bf16x8*)&b;
    }
    const float cq = FOX ? cum2[tq < TT ? tq : TT - 1] : 0.f;
    f32x16 o0, o1;
#pragma unroll
    for (int r = 0; r < 16; ++r) { o0[r] = 0.f; o1[r] = 0.f; }
    float mrow = -1e30f, lrow = 0.f;
    const int jmax = (4 * qt + 3) < 65 ? (4 * qt + 3) : 65;
    const int jw = (q0 + 31) >> 6;
    u32x4 kr0, kr1, vr; float cr = 0.f;
    const int kkey0 = tid / (DK / 8), kseg0 = tid % (DK / 8), kkey1 = (tid + 512) / (DK / 8), kseg1 = (tid + 512) % (DK / 8);
    const int vkey = tid >> 3, vseg = tid & 7;
    const int vpos = (vkey & ~15) + 8 * ((vkey >> 2) & 1) + 4 * ((vkey >> 3) & 1) + (vkey & 3);
#define ATT_PREFETCH(j) do { const size_t kb_ = (size_t)(j) * 64; \
        kr0 = *(const u32x4*)(Kp + (kb_ + kkey0) * ldk + kseg0 * 8); \
        if (KPIECES > 512 && tid + 512 < KPIECES) kr1 = *(const u32x4*)(Kp + (kb_ + kkey1) * ldk + kseg1 * 8); \
        vr = *(const u32x4*)(Vp + (kb_ + vkey) * ldv + vseg * 8); \
        if (FOX && tid < 64) cr = cum2[kb_ + tid]; } while (0)
    kr1 = (u32x4){0u, 0u, 0u, 0u};
    ATT_PREFETCH(1);
    for (int j = 1; j <= jmax; ++j) {
        __syncthreads();
        *(LAS u32x4*)(Ks + kkey0 * KST + kseg0 * 8) = kr0;
        if (KPIECES > 512 && tid + 512 < KPIECES) *(LAS u32x4*)(Ks + kkey1 * KST + kseg1 * 8) = kr1;
        {
            const unsigned w[4] = {vr.x, vr.y, vr.z, vr.w};
#pragma unroll
            for (int e = 0; e < 4; ++e) { Vt[(vseg * 8 + 2 * e) * 72 + vpos] = (bf16_t)(w[e] & 0xffffu); Vt[(vseg * 8 + 2 * e + 1) * 72 + vpos] = (bf16_t)(w[e] >> 16); }
        }
        if (FOX && tid < 64) Cs[tid] = cr;
        __syncthreads();
        if (j + 1 <= jmax) ATT_PREFETCH(j + 1);
        if (wact && j <= jw) {
            f32x16 s0, s1;
#pragma unroll
            for (int r = 0; r < 16; ++r) { s0[r] = 0.f; s1[r] = 0.f; }
#pragma unroll
            for (int ds = 0; ds < NDS; ++ds) {
                const bf16x8 a0 = *(const LAS bf16x8*)(Ks + qi * KST + ds * 16 + 8 * half);
                const bf16x8 a1 = *(const LAS bf16x8*)(Ks + (32 + qi) * KST + ds * 16 + 8 * half);
                s0 = __builtin_amdgcn_mfma_f32_32x32x16_bf16(a0, qf[ds], s0, 0, 0, 0);
                s1 = __builtin_amdgcn_mfma_f32_32x32x16_bf16(a1, qf[ds], s1, 0, 0, 0);
            }
            const bool need_mask = (j == 1) || (j * 64 + 63 > q0);
            float mx = -1e30f;
#pragma unroll
            for (int g = 0; g < 4; ++g) {
                f32x4 c0v = (f32x4){0.f, 0.f, 0.f, 0.f}, c1v = c0v;
                if (FOX) { c0v = *(const LAS f32x4*)(Cs + g * 8 + half * 4); c1v = *(const LAS f32x4*)(Cs + 32 + g * 8 + half * 4); }
#pragma unroll
                for (int e = 0; e < 4; ++e) { const int r = g * 4 + e; const int kl = g * 8 + half * 4 + e;
                    float x0 = s0[r] * c1, x1 = s1[r] * c1;
                    if (FOX) { x0 += cq - c0v[e]; x1 += cq - c1v[e]; }
                    if (need_mask) { const int key0 = j * 64 + kl, key1 = key0 + 32;
                        if (key0 < PADL || key0 > tq) x0 = -1e30f;
                        if (key1 < PADL || key1 > tq) x1 = -1e30f; }
                    s0[r] = x0; s1[r] = x1; mx = fmaxf(mx, fmaxf(x0, x1)); }
            }
            mx = fmaxf(mx, __shfl_xor(mx, 32));
            const float mnew = fmaxf(mrow, mx), alpha = exp2f(mrow - mnew);
            float rs = 0.f;
#pragma unroll
            for (int r = 0; r < 16; ++r) { s0[r] = exp2f(s0[r] - mnew); s1[r] = exp2f(s1[r] - mnew); rs += s0[r] + s1[r]; }
            rs += __shfl_xor(rs, 32);
            lrow = lrow * alpha + rs; mrow = mnew;
#pragma unroll
            for (int r = 0; r < 16; ++r) { o0[r] *= alpha; o1[r] *= alpha; }
#pragma unroll
            for (int s = 0; s < 4; ++s) {
                bf16x8 pf;
                {
                    unsigned w[4];
#pragma unroll
                    for (int e = 0; e < 4; ++e) { const int r = 8 * (s & 1) + 2 * e; w[e] = (s < 2) ? cvt_pk_bf16(s0[r], s0[r + 1]) : cvt_pk_bf16(s1[r], s1[r + 1]); }
                    u32x4 ww = (u32x4){w[0], w[1], w[2], w[3]}; pf = *(bf16x8*)&ww;
                }
                const bf16x8 v0 = *(const LAS bf16x8*)(Vt + qi * 72 + 16 * s + 8 * half);
                const bf16x8 v1 = *(const LAS bf16x8*)(Vt + (32 + qi) * 72 + 16 * s + 8 * half);
                o0 = __builtin_amdgcn_mfma_f32_32x32x16_bf16(v0, pf, o0, 0, 0, 0);
                o1 = __builtin_amdgcn_mfma_f32_32x32x16_bf16(v1, pf, o1, 0, 0, 0);
            }
        }
    }
#undef ATT_PREFETCH
    if (tq < TT) {
        const float inv = (tq >= PADL && lrow > 0.f) ? 1.0f / lrow : 0.f;
        bf16_t* orow = Op + (size_t)tq * 1024;
#pragma unroll
        for (int g = 0; g < 4; ++g) {
            u32x2 w; w.x = cvt_pk_bf16(o0[4 * g] * inv, o0[4 * g + 1] * inv); w.y = cvt_pk_bf16(o0[4 * g + 2] * inv, o0[4 * g + 3] * inv);
            *(u32x2*)(orow + 8 * g + 4 * half) = w;
            w.x = cvt_pk_bf16(o1[4 * g] * inv, o1[4 * g + 1] * inv); w.y = cvt_pk_bf16(o1[4 * g + 2] * inv, o1[4 * g + 3] * inv);
            *(u32x2*)(orow + 32 + 8 * g + 4 * half) = w;
        }
    }
}
__device__ void phase_attn(const KP& p, LAS unsigned char* lds, int vb, int nvb, int kinds) {
    const bf16_t* P = (const bf16_t*)(p.ws + OFF_BIG);
    const bf16_t* Qm = (const bf16_t*)(p.ws + OFF_QM); const bf16_t* Km = (const bf16_t*)(p.ws + OFF_KM); const bf16_t* Vm = (const bf16_t*)(p.out + OO_VM);
    const float* cum = (const float*)(p.ws + OFF_CUM);
    bf16_t* YS = (bf16_t*)(p.out + OO_YS);
    const int per = (kinds == 3) ? 128 : 64, nitems = 17 * per;
    for (int rnd = 0;; ++rnd) {
        const int idx = rnd * nvb + ((rnd & 1) ? (nvb - 1 - vb) : vb);
        if (rnd * nvb >= nitems) break;
        if (idx >= nitems) continue;
        const int qt = 16 - idx / per; const int rem = idx % per;
        int kind, bh;
        if (kinds == 3) { kind = rem & 1; bh = rem >> 1; } else { kind = (kinds == 2); bh = rem; }
        const int b = bh >> 2, h = bh & 3;
        if (kind == 0)
            attn_item<64, true>(lds, P + (size_t)b * TT * PN + PC_FQ + h * 64, PN, P + (size_t)b * TT * PN + PC_FK + h * 64, PN, P + (size_t)b * TT * PN + PC_FV + h * 64, PN,
                                cum + (size_t)bh * TT, nullptr, 0.125f * LOG2E, YS + (size_t)b * TT * 1024 + h * 64, qt);
        else
            attn_item<96, false>(lds, Qm + (size_t)b * TT * 384 + h * 96, 384, Km + (size_t)b * TT * 384 + h * 96, 384, Vm + (size_t)b * TT * 256 + h * 64, 256,
                                 nullptr, (const float*)(p.ws + OFF_ROPE), 0.10206207261596577f * LOG2E, YS + (size_t)b * TT * 1024 + 256 + h * 64, qt);
    }
    __syncthreads();
}

constexpr int NPL = 16, NPH = 2 + 2 * NPL;

__device__ void run_phase(const KP& p, int ph, LAS unsigned char* lds) {
    const int G = ogdim(), c = obid();
    char* ws = p.ws;
    int kind = -1, l = 0;
    int s = -1;
    if (ph == 0) { if (EN_MASK & 1) phase_prep(p, lds); return; }
    if (ph == NPH - 1) { phase_rmsnorm(p, p.inp(30), 3); return; }
    l = (ph - 1) / NPL; s = (ph - 1) % NPL;
    const char* W = ws + OFF_W + (size_t)l * W_LAYER;
    pg8::Sched S;
    const void* gA = nullptr; const void* gB = nullptr; int gK = 0, lda = 0, ldb = 0, half = 0; float alpha = 0.f;
    switch (s) {
    case 0: phase_rmsnorm(p, p.inp(2) + l * DM, l == 0 ? 2 : 0); return;
    case 3: phase_rmsnorm(p, p.inp(5) + l * DM, 1); return;
    case 13: phase_rmsnorm(p, p.inp(27) + l * DM, 0); return;
    case 1: kind = 0; gA = ws + OFF_UN; gB = W + W_WI1; break;
    case 14: kind = 0; gA = ws + OFF_UN; gB = W + W_WI2; break;
    case 2: kind = 1; gA = ws + OFF_BIG; gB = W + W_WO1; gK = FF; lda = FF; ldb = FF; alpha = 0.5f; break;
    case 15: kind = 1; gA = ws + OFF_BIG; gB = W + W_WO2; gK = FF; lda = FF; ldb = FF; alpha = 0.5f; break;
    case 12: kind = 1; gA = ws + OFF_MERGED; gB = W + W_WOUT; gK = DM; lda = DM; ldb = DM; alpha = 1.0f; break;
    case 4: kind = 2; break;
    case 5: {
        phase_mla_pre(p, l);
        phase_fox_cum(p, l);
        if (c < 64) { if (EN_MASK & 2) lru_item(p, l, lds, c); }
        else if (EN_MASK & 4) for (int cid = c - 64; cid < NB * 4 * 66; cid += G - 64) gdn_pre_chunk(p, l, lds, cid);
        return; }
    case 6: kind = 3; break;
    case 7: if (EN_MASK & 8) phase_attn(p, lds, c, G, 3); return;
    case 8: kind = 4; half = 0; break;
    case 10: kind = 4; half = 1; break;
    case 9: kind = 5; half = 0; break;
    case 11: kind = 5; half = 1; break;
    default: return;
    }
    if (!(EN_MASK & 32)) return;
    if (!((GK_MASK >> kind) & 1)) return;
    switch (kind) {
    case 0: if ((GK_MASK >> 0) & 1) { S.init(NT / 256, 2 * FF / 256, G, c, 0, gA, DM, gB, DM); pg8::EpiSwiglu E{(bf16_t*)(ws + OFF_BIG)}; pg8::gemm_phase(lds, DM, DM, DM, S, E); break; }
    case 1: if ((GK_MASK >> 1) & 1) { S.init(NT / 256, DM / 256, G, c, 0, gA, lda, gB, ldb); pg8::EpiResid E{(float*)(ws + OFF_H), alpha}; pg8::gemm_phase(lds, gK, lda, ldb, S, E); break; }
    case 2: if ((GK_MASK >> 2) & 1) { S.init(NT / 256, PN / 256, G, c, 0, ws + OFF_UN, DM, W + W_WIN, DM); pg8::EpiBf16 E{(bf16_t*)(ws + OFF_BIG), PN, 0}; pg8::gemm_phase(lds, DM, DM, DM, S, E); break; }
    case 3: if ((GK_MASK >> 3) & 1) { S.init(NT / 256, 4, G, c, 0, ws + OFF_AMLA, 384, W + W_WUP, 384);
              pg8::EpiMlaUp E{(bf16_t*)(ws + OFF_QM), (bf16_t*)(ws + OFF_KM), (bf16_t*)(p.out + OO_VM)}; pg8::gemm_phase(lds, 384, 384, 384, S, E);
              __syncthreads();
              if (EN_MASK & 16) for (int bh = c; bh < NB * 4; bh += G) gdn_scan_item(p, l, lds, bh);
              break; }
    case 4: if ((GK_MASK >> 4) & 1) { S.init(HR / 256, 16, G, c, 1, p.out + OO_YS + (size_t)half * HR * 1024 * 2, 1024, W + W_WB, 256);
              pg8::EpiBf16 E{(bf16_t*)(ws + OFF_BIG), 1024, 1}; pg8::gemm_phase(lds, 256, 1024, 256, S, E); break; }
    case 5: if ((GK_MASK >> 5) & 1) { S.init(HR / 256, 16, G, c, 0, ws + OFF_UN + (size_t)half * HR * DM * 2, DM, W + W_WG, DM);
              pg8::EpiGate E{(bf16_t*)(ws + OFF_MERGED), (const bf16_t*)(ws + OFF_BIG), p.inp(24) + (size_t)l * 4 * DM, half * HR}; pg8::gemm_phase(lds, DM, DM, DM, S, E); break; }
    default: break;
    }
}

__global__ void __launch_bounds__(NTHR, 2) mega_kernel(KPA pa) {
    extern __shared__ __attribute__((aligned(16))) unsigned char smem[];
    LAS unsigned char* lds = (LAS unsigned char*)smem;
    for (int ph = pa.lo; ph < pa.hi; ++ph) {
        KP p; p.a = &pa; p.z = 0; p.ws = pa.ws; p.out = pa.out;
        asm volatile("" : "+s"(p.z), "+s"(p.ws), "+s"(p.out));
        run_phase(p, ph, lds);
        if (ph + 1 < pa.hi) { cg::this_grid().sync(); }
    }
}

extern "C" void kernel_launch(void* const* d_in, const int* in_sizes, int n_in, void* d_out, int out_size, void* d_ws, size_t ws_size, hipStream_t stream) {
    static int grid = 0;
    if (grid == 0) {
        if (n_in != 31 || ws_size < WS_END) { fprintf(stderr, "kernel_launch: unexpected n_in %d / ws %zu (need %zu)\n", n_in, ws_size, (size_t)WS_END); grid = -1; return; }
        int dev = 0, cus = 0, per_cu = 0;
        hipGetDevice(&dev); hipDeviceGetAttribute(&cus, hipDeviceAttributeMultiprocessorCount, dev);
        if (hipFuncSetAttribute((const void*)mega_kernel, hipFuncAttributeMaxDynamicSharedMemorySize, LDS_BYTES) != hipSuccess) { fprintf(stderr, "kernel_launch: hipFuncSetAttribute failed\n"); grid = -1; return; }
        if (hipOccupancyMaxActiveBlocksPerMultiprocessor(&per_cu, (const void*)mega_kernel, NTHR, LDS_BYTES) != hipSuccess || per_cu < 1) { fprintf(stderr, "kernel_launch: occupancy query says %d\n", per_cu); per_cu = 1; }
        (void)hipGetLastError();
        grid = cus;
    }
    if (grid < 0) return;
    KPA a; memset(&a, 0, sizeof(a));
    for (int i = 0; i < 31; ++i) a.in[i] = (const float*)d_in[i];
    a.ws = (char*)d_ws; a.out = (char*)d_out;
#if ONE_LAUNCH
    a.lo = 0; a.hi = NPH;
    void* args[] = {&a};
    hipError_t e = hipLaunchCooperativeKernel((const void*)mega_kernel, dim3(grid), dim3(NTHR), args, LDS_BYTES, stream);
    if (e != hipSuccess) fprintf(stderr, "cooperative launch failed: %s (grid %d)\n", hipGetErrorString(e), grid);
#else
    for (int ph = 0; ph < NPH; ++ph) { a.lo = ph; a.hi = ph + 1; hipLaunchKernelGGL(mega_kernel, dim3(grid), dim3(NTHR), LDS_BYTES, stream, a); }
#endif
}
```

```cpp
#include <hip/hip_runtime.h>
#include <hip/hip_cooperative_groups.h>
#include <cstdio>
#include <cstring>
namespace cg = cooperative_groups;

#ifndef REP_MASK
#define REP_MASK 0
#endif
#ifndef GK_MASK
#define GK_MASK 0xff
#endif
#ifndef EN_MASK
#define EN_MASK 0xff
#endif
#ifndef ONE_LAUNCH
#define ONE_LAUNCH 1
#endif

#define LAS __attribute__((address_space(3)))
typedef unsigned short bf16_t;
typedef short bf16x8 __attribute__((ext_vector_type(8)));
typedef float f32x4 __attribute__((ext_vector_type(4)));
typedef float f32x16 __attribute__((ext_vector_type(16)));
typedef unsigned u32x4 __attribute__((ext_vector_type(4)));
typedef unsigned u32x2 __attribute__((ext_vector_type(2)));

constexpr int NB = 16, TT = 4224, NT = NB * TT, DM = 1024, FF = 2816, PADL = 112, PN = 2560;
constexpr int HR = NT / 2;
constexpr float EPS = 1e-6f, LOG2E = 1.4426950408889634f;
constexpr int NTHR = 512, LDS_BYTES = 131072;
constexpr int PC_FQ = 0, PC_FK = 256, PC_FV = 512, PC_CQ = 768, PC_CKV = 960, PC_KR = 1088, PC_GQ = 1120, PC_GK = 1376, PC_GV = 1632,
              PC_GG = 1888, PC_LRU = 2144, PC_FF = 2400, PC_GA = 2404, PC_GB = 2408;
constexpr size_t W_WI1 = 0, W_WO1 = W_WI1 + 5632ull * 1024 * 2, W_WI2 = W_WO1 + 1024ull * 2816 * 2, W_WO2 = W_WI2 + 5632ull * 1024 * 2,
                 W_WIN = W_WO2 + 1024ull * 2816 * 2, W_WUP = W_WIN + 2560ull * 1024 * 2, W_WG = W_WUP + 1024ull * 384 * 2,
                 W_WB = W_WG + 4096ull * 1024 * 2, W_WOUT = W_WB + 4096ull * 256 * 2, W_LAYER = W_WOUT + 1024ull * 1024 * 2;
constexpr size_t OFF_H = 0, OFF_W = OFF_H + (size_t)NT * DM * 4, OFF_UN = OFF_W + 2 * W_LAYER, OFF_BIG = OFF_UN + (size_t)NT * DM * 2,
                 OFF_REST = OFF_BIG + (size_t)NT * FF * 2;
constexpr size_t OFF_AMLA = OFF_REST, OFF_QM = OFF_AMLA + (size_t)NT * 384 * 2, OFF_KM = OFF_QM + (size_t)NT * 384 * 2,
                 OFF_CUM = OFF_KM + (size_t)NT * 384 * 2, OFF_ROPE = OFF_CUM + (size_t)NB * 4 * TT * 4, WS_END = OFF_ROPE + (size_t)TT * 32 * 4;
constexpr size_t OFF_MERGED = OFF_REST;
static_assert(WS_END <= (1ull << 30), "workspace");
constexpr size_t OO_YS = 0, OO_VM = OO_YS + (size_t)NT * 1024 * 2, OO_GW = OO_VM + (size_t)NT * 256 * 2,
                 OO_GU = OO_GW + (size_t)NB * 4 * 66 * 4096 * 2, OO_END = OO_GU + (size_t)NB * 4 * 66 * 4096 * 2;
static_assert(OO_END <= (size_t)NB * 4096 * 1024 * 4, "out scratch");

struct KP { const float* in[31]; char* ws; char* out; int lo, hi;
    __device__ __forceinline__ const float* inp(int i) const { return in[i]; } };
typedef KP KPA;

__device__ __forceinline__ unsigned cvt_pk_bf16(float lo, float hi) { unsigned r; asm("v_cvt_pk_bf16_f32 %0, %1, %2" : "=v"(r) : "v"(lo), "v"(hi)); return r; }
__device__ __forceinline__ bf16_t f2bf(float f) { return (bf16_t)(cvt_pk_bf16(f, 0.f) & 0xffffu); }
__device__ __forceinline__ float bf2f(bf16_t b) { return __uint_as_float(((unsigned)b) << 16); }
__device__ __forceinline__ float bflo(unsigned w) { return __uint_as_float(w << 16); }
__device__ __forceinline__ float bfhi(unsigned w) { return __uint_as_float(w & 0xffff0000u); }
__device__ __forceinline__ float sigmoidf_(float x) { return __builtin_amdgcn_rcpf(1.0f + __expf(-x)); }
__device__ __forceinline__ float siluf_(float x) { return x * sigmoidf_(x); }
__device__ __forceinline__ int otid() { int t = threadIdx.x; asm volatile("" : "+v"(t)); return t; }
__device__ __forceinline__ int obid() { return (int)blockIdx.x; }
__device__ __forceinline__ int ogdim() { return (int)gridDim.x; }
__device__ __forceinline__ float wave_sum(float v) {
#pragma unroll
    for (int o = 32; o >= 1; o >>= 1) v += __shfl_xor(v, o);
    return v;
}

namespace pg8 {
constexpr int BM = 256, BK = 64, HALF = 128, HTB = HALF * BK * 2, NXCD = 8, WGM = 8;
__device__ __forceinline__ int lds_byte(int r, int c) { const int st = (r >> 4) * 2 + (c >> 5), rr = r & 15, cc = c & 31, ob = rr * 64 + cc * 2; return st * 1024 + (ob ^ (((ob >> 9) & 1) << 5)); }
__device__ __forceinline__ void stage_rc(int b, int& R, int& C) { const int st = b / 1024, sb = b % 1024, swz = sb ^ (((sb >> 9) & 1) << 5); R = (st >> 1) * 16 + swz / 64; C = (st & 1) * 32 + (swz % 64) / 2; }
__device__ __forceinline__ int perm32(int rho) { const int n = rho >> 4, i = rho & 15; return 8 * (i >> 2) + 4 * n + (i & 3); }

__device__ __forceinline__ const char* uptr(const char* p) { const unsigned long long v = (unsigned long long)p;
    const unsigned lo = __builtin_amdgcn_readfirstlane((unsigned)v), hi = __builtin_amdgcn_readfirstlane((unsigned)(v >> 32)); return (const char*)(((unsigned long long)hi << 32) | lo); }
struct Unit { int pm, pn; const char* pa; const char* pb; };
struct Sched {
    int nM, nN, nwg, G, c, mode; const char* A; const char* B; size_t tA, tB;
    __device__ void init(int nM_, int nN_, int G_, int c_, int mode_, const void* A_, int lda, const void* B_, int ldb) {
        nM = nM_; nN = nN_; nwg = nM * nN; G = G_; c = c_; mode = mode_; A = (const char*)A_; B = (const char*)B_; tA = (size_t)BM * lda * 2; tB = (size_t)BM * ldb * 2; }
    __device__ bool next(int i, Unit& u) const {
        const long L = (long)i * G + c; if (L >= nwg) return false;
        int wgid = (int)L; { const int q = nwg / NXCD, r = nwg % NXCD, xcd = wgid % NXCD, off = wgid / NXCD; wgid = (xcd < r ? xcd * (q + 1) : r * (q + 1) + (xcd - r) * q) + off; }
        const int nig = WGM * nN, gid = wgid / nig, fm = gid * WGM, gsz = (nM - fm) < WGM ? (nM - fm) : WGM;
        u.pm = fm + ((wgid % nig) % gsz); u.pn = (wgid % nig) / gsz;
        if (mode == 0) { u.pa = A + (size_t)u.pm * tA; u.pb = B + (size_t)u.pn * tB; }
        else { const int g = u.pn >> 2, q = u.pn & 3; u.pa = A + (size_t)u.pm * tA + (size_t)g * 512; u.pb = B + (size_t)g * (1024ull * 256 * 2) + (size_t)q * tB; }
        return true;
    }
};

template <class Epi>
__device__ __forceinline__ void gemm_phase(LAS unsigned char* lds, int K, int lda, int ldb, const Sched& S, const Epi& E) {
    const int tid = otid(), wid = __builtin_amdgcn_readfirstlane(tid >> 6), lane = tid & 63, wr = wid >> 2, wc = wid & 3, fr = lane & 15, fq = lane >> 4;
    const int nt = K / BK;
    unsigned voffA[2], voffB[2];
#pragma unroll
    for (int i = 0; i < 2; ++i) { int R, C; stage_rc(tid * 16 + i * 8192, R, C); const int Rb = Epi::PERM ? ((R & ~31) + perm32(R & 31)) : R;
        voffA[i] = (unsigned)(R * lda + C) * 2u; voffB[i] = (unsigned)(Rb * ldb + C) * 2u; }
    const size_t kstep = (size_t)(BK * 2);
    const size_t hA = (size_t)HALF * lda * 2, hB = (size_t)HALF * ldb * 2;
    const unsigned ldsw = (unsigned)wid * 1024u;
    const int aoff = lds_byte(wr * 64 + fr, fq * 8), boff = lds_byte(wc * 32 + fr, fq * 8);
#define PG8_SA(b, h) (((b) * 2 + (h)) * HTB)
#define PG8_SB(b, h) ((4 + (b) * 2 + (h)) * HTB)
#define PG8_STAGE(bufoff, gbase, voff) do { const char* _ub = (const char*)(gbase); _Pragma("unroll") for (int _i = 0; _i < 2; ++_i) { unsigned _vo = (voff)[_i]; asm volatile("" : "+v"(_vo)); \
        __builtin_amdgcn_global_load_lds((const unsigned*)(_ub + _vo), (LAS unsigned*)(lds + (bufoff) + ldsw + _i * 8192), 16, 0, 0); } } while (0)
#define PG8_LDA(dst, b, h) do { _Pragma("unroll") for (int m = 0; m < 4; ++m) _Pragma("unroll") for (int k = 0; k < 2; ++k) dst[m][k] = *(const LAS bf16x8*)(lds + PG8_SA(b, h) + aoff + m * 2048 + k * 1024); } while (0)
#define PG8_LDB(dst, b, h) do { _Pragma("unroll") for (int n = 0; n < 2; ++n) _Pragma("unroll") for (int k = 0; k < 2; ++k) dst[n][k] = *(const LAS bf16x8*)(lds + PG8_SB(b, h) + boff + n * 2048 + k * 1024); } while (0)
#define PG8_MMA(ai, bj, At, Bt) do { __builtin_amdgcn_s_setprio(1); _Pragma("unroll") for (int m = 0; m < 4; ++m) _Pragma("unroll") for (int n = 0; n < 2; ++n) _Pragma("unroll") for (int k = 0; k < 2; ++k) \
        acc[ai][bj][m][n] = __builtin_amdgcn_mfma_f32_16x16x32_bf16(Bt[n][k], At[m][k], acc[ai][bj][m][n], 0, 0, 0); __builtin_amdgcn_s_setprio(0); } while (0)
#define PG8_WAIT_V(n) asm volatile("s_waitcnt vmcnt(" #n ")" ::: "memory")
#define PG8_WAIT_L(n) asm volatile("s_waitcnt lgkmcnt(" #n ")" ::: "memory")
#define PG8_BAR __builtin_amdgcn_s_barrier()
#define PG8_SCHED __builtin_amdgcn_sched_barrier(0)
    Unit cur, nxt; int ui = 0;
    if (!S.next(0, cur)) return;
    f32x4 acc[2][2][4][2];
#pragma unroll
    for (int a = 0; a < 2; ++a)
#pragma unroll
        for (int b = 0; b < 2; ++b)
#pragma unroll
            for (int m = 0; m < 4; ++m)
#pragma unroll
                for (int n = 0; n < 2; ++n) acc[a][b][m][n] = (f32x4){0.f, 0.f, 0.f, 0.f};
    bf16x8 At[4][2], B0[2][2], B1[2][2];
    const char* cA = cur.pa; const char* cB = cur.pb;
    PG8_STAGE(PG8_SB(0, 0), cB, voffB); PG8_STAGE(PG8_SA(0, 0), cA, voffA); PG8_STAGE(PG8_SB(0, 1), cB + hB, voffB); PG8_STAGE(PG8_SA(0, 1), cA + hA, voffA);
    if (wr == 1) PG8_BAR;
    PG8_WAIT_V(4); PG8_BAR;
    PG8_STAGE(PG8_SB(1, 0), cB + kstep, voffB); PG8_STAGE(PG8_SA(1, 0), cA + kstep, voffA); PG8_STAGE(PG8_SB(1, 1), cB + hB + kstep, voffB);
    PG8_WAIT_V(6); PG8_BAR;
    for (;;) {
        const bool has_next = S.next(ui + 1, nxt);
        const char* nA = has_next ? nxt.pa : cA; const char* nB = has_next ? nxt.pb : cB;
        for (int t = 0; t < nt; t += 2) {
            const bool last = (t == nt - 2);
            const char* a1 = cA + (size_t)(t + 1) * kstep;
            const char* a2 = last ? nA : cA + (size_t)(t + 2) * kstep; const char* b2 = last ? nB : cB + (size_t)(t + 2) * kstep;
            const char* a3 = a2 + kstep; const char* b3 = b2 + kstep;
            PG8_LDB(B0, 0, 0); PG8_SCHED; PG8_LDA(At, 0, 0); PG8_STAGE(PG8_SA(1, 1), a1 + hA, voffA);
            PG8_WAIT_L(8); PG8_BAR; PG8_WAIT_L(0); PG8_MMA(0, 0, At, B0); PG8_BAR; PG8_SCHED;
            PG8_LDB(B1, 0, 1); PG8_STAGE(PG8_SB(0, 0), b2, voffB);
            PG8_BAR; PG8_WAIT_L(0); PG8_MMA(0, 1, At, B1); PG8_BAR;
            PG8_LDA(At, 0, 1); PG8_STAGE(PG8_SA(0, 0), a2, voffA);
            PG8_BAR; PG8_WAIT_L(0); PG8_MMA(1, 0, At, B0); PG8_BAR; PG8_SCHED;
            PG8_STAGE(PG8_SB(0, 1), b2 + hB, voffB);
            PG8_WAIT_V(6); PG8_BAR; PG8_MMA(1, 1, At, B1); PG8_BAR;
            PG8_LDB(B0, 1, 0); PG8_SCHED; PG8_LDA(At, 1, 0); PG8_STAGE(PG8_SA(0, 1), a2 + hA, voffA);
            PG8_WAIT_L(8); PG8_BAR; PG8_WAIT_L(0); PG8_MMA(0, 0, At, B0); PG8_BAR; PG8_SCHED;
            PG8_LDB(B1, 1, 1); PG8_STAGE(PG8_SB(1, 0), b3, voffB);
            PG8_BAR; PG8_WAIT_L(0); PG8_MMA(0, 1, At, B1); PG8_BAR;
            PG8_LDA(At, 1, 1); PG8_STAGE(PG8_SA(1, 0), a3, voffA);
            PG8_BAR; PG8_WAIT_L(0); PG8_MMA(1, 0, At, B0); PG8_BAR; PG8_SCHED;
            PG8_STAGE(PG8_SB(1, 1), b3 + hB, voffB);
            PG8_WAIT_V(6); PG8_BAR; PG8_MMA(1, 1, At, B1); PG8_BAR;
        }
        E(acc, cur, wr, wc, fr, fq);
        if (!has_next) break;
#pragma unroll
        for (int a = 0; a < 2; ++a)
#pragma unroll
            for (int b = 0; b < 2; ++b)
#pragma unroll
                for (int m = 0; m < 4; ++m)
#pragma unroll
                    for (int n = 0; n < 2; ++n) acc[a][b][m][n] = (f32x4){0.f, 0.f, 0.f, 0.f};
        cur = nxt; cA = nA; cB = nB; ++ui;
    }
    PG8_WAIT_V(0);
    if (wr == 0) PG8_BAR;
    PG8_BAR;
#undef PG8_SA
#undef PG8_SB
#undef PG8_STAGE
#undef PG8_LDA
#undef PG8_LDB
#undef PG8_MMA
#undef PG8_WAIT_V
#undef PG8_WAIT_L
#undef PG8_BAR
#undef PG8_SCHED
}

typedef f32x4 Acc[2][2][4][2];

struct EpiSwiglu {
    static constexpr bool PERM = true;
    bf16_t* O;
    __device__ __forceinline__ void operator()(const Acc& acc, const Unit& u, int wr, int wc, int fr, int fq) const {
        const int row0 = u.pm * BM + wr * 64 + fr, col0 = u.pn * 128 + wc * 32 + 8 * fq;
#pragma unroll
        for (int ai = 0; ai < 2; ++ai)
#pragma unroll
            for (int m = 0; m < 4; ++m) {
                const f32x4 g0 = acc[ai][0][m][0], g1 = acc[ai][0][m][1], u0 = acc[ai][1][m][0], u1 = acc[ai][1][m][1];
                u32x4 w;
                w.x = cvt_pk_bf16(siluf_(g0[0]) * u0[0], siluf_(g0[1]) * u0[1]); w.y = cvt_pk_bf16(siluf_(g0[2]) * u0[2], siluf_(g0[3]) * u0[3]);
                w.z = cvt_pk_bf16(siluf_(g1[0]) * u1[0], siluf_(g1[1]) * u1[1]); w.w = cvt_pk_bf16(siluf_(g1[2]) * u1[2], siluf_(g1[3]) * u1[3]);
                *(u32x4*)(O + (size_t)(row0 + ai * HALF + m * 16) * FF + col0) = w;
            }
    }
};
struct EpiResid {
    static constexpr bool PERM = false;
    float* H; float alpha;
    __device__ __forceinline__ void operator()(const Acc& acc, const Unit& u, int wr, int wc, int fr, int fq) const {
        const int row0 = u.pm * BM + wr * 64 + fr, col0 = u.pn * BM + wc * 32 + 4 * fq;
#pragma unroll
        for (int ai = 0; ai < 2; ++ai)
#pragma unroll
            for (int m = 0; m < 4; ++m) { float* rowp = H + (size_t)(row0 + ai * HALF + m * 16) * DM + col0;
#pragma unroll
                for (int bj = 0; bj < 2; ++bj)
#pragma unroll
                    for (int n = 0; n < 2; ++n) { f32x4 v = *(f32x4*)(rowp + bj * HALF + n * 16); v += acc[ai][bj][m][n] * alpha; *(f32x4*)(rowp + bj * HALF + n * 16) = v; } }
    }
};
struct EpiBf16 {
    static constexpr bool PERM = true;
    bf16_t* O; int ldc; int ymode;
    __device__ __forceinline__ void operator()(const Acc& acc, const Unit& u, int wr, int wc, int fr, int fq) const {
        const int row0 = u.pm * BM + wr * 64 + fr;
        bf16_t* base = O; int colt = u.pn * BM;
        if (ymode) { base += (size_t)(u.pn >> 2) * HR * 1024; colt = (u.pn & 3) * BM; }
        const int col0 = colt + wc * 32 + 8 * fq;
#pragma unroll
        for (int ai = 0; ai < 2; ++ai)
#pragma unroll
            for (int m = 0; m < 4; ++m) { bf16_t* rowp = base + (size_t)(row0 + ai * HALF + m * 16) * ldc + col0;
#pragma unroll
                for (int bj = 0; bj < 2; ++bj) { const f32x4 v0 = acc[ai][bj][m][0], v1 = acc[ai][bj][m][1];
                    u32x4 w; w.x = cvt_pk_bf16(v0[0], v0[1]); w.y = cvt_pk_bf16(v0[2], v0[3]); w.z = cvt_pk_bf16(v1[0], v1[1]); w.w = cvt_pk_bf16(v1[2], v1[3]);
                    *(u32x4*)(rowp + bj * HALF) = w; } }
    }
};
struct EpiMlaUp {
    static constexpr bool PERM = false;
    bf16_t* Qm; bf16_t* Km; bf16_t* Vm;
    __device__ __forceinline__ void operator()(const Acc& acc, const Unit& u, int wr, int wc, int fr, int fq) const {
        const int row0 = u.pm * BM + wr * 64 + fr;
#pragma unroll
        for (int bj = 0; bj < 2; ++bj) {
            const int g32 = u.pn * 8 + bj * 4 + wc;
            if (g32 >= 28) continue;
            if (g32 < 12) {
                {
#pragma unroll
                    for (int ai = 0; ai < 2; ++ai)
#pragma unroll
                        for (int m = 0; m < 4; ++m) { const size_t r = (size_t)(row0 + ai * HALF + m * 16);
#pragma unroll
                            for (int n = 0; n < 2; ++n) { const f32x4 v = acc[ai][bj][m][n]; u32x2 w; w.x = cvt_pk_bf16(v[0], v[1]); w.y = cvt_pk_bf16(v[2], v[3]);
                                *(u32x2*)(Qm + r * 384 + g32 * 32 + n * 16 + 4 * fq) = w; } }
                }
            } else {
                const int cc = (g32 - 12) * 32, hh = cc >> 7, w_ = cc & 127;
                bf16_t* dst; int ld;
                if (w_ < 64) { dst = Km + hh * 96 + w_; ld = 384; } else { dst = Vm + hh * 64 + (w_ - 64); ld = 256; }
#pragma unroll
                for (int ai = 0; ai < 2; ++ai)
#pragma unroll
                    for (int m = 0; m < 4; ++m) { const size_t r = (size_t)(row0 + ai * HALF + m * 16);
#pragma unroll
                        for (int n = 0; n < 2; ++n) { const f32x4 v = acc[ai][bj][m][n]; u32x2 w; w.x = cvt_pk_bf16(v[0], v[1]); w.y = cvt_pk_bf16(v[2], v[3]);
                            *(u32x2*)(dst + r * ld + n * 16 + 4 * fq) = w; } }
            }
        }
    }
};
struct EpiGate {
    static constexpr bool PERM = false;
    bf16_t* Mg; const bf16_t* Y; const float* bg; int rowoff;
    __device__ __forceinline__ void operator()(const Acc& acc, const Unit& u, int wr, int wc, int fr, int fq) const {
        const int row0 = u.pm * BM + wr * 64 + fr, colr = u.pn * 64 + wc * 16 + 4 * fq;
        f32x4 bv[4];
#pragma unroll
        for (int g = 0; g < 4; ++g) bv[g] = *(const f32x4*)(bg + g * 1024 + colr);
#pragma unroll
        for (int ai = 0; ai < 2; ++ai)
#pragma unroll
            for (int m = 0; m < 4; ++m) { const int rl = row0 + ai * HALF + m * 16;
                f32x4 s = (f32x4){0.f, 0.f, 0.f, 0.f};
#pragma unroll
                for (int bj = 0; bj < 2; ++bj)
#pragma unroll
                    for (int n = 0; n < 2; ++n) { const int g = 2 * bj + n; const f32x4 a = acc[ai][bj][m][n] + bv[g];
                        const u32x2 y = *(const u32x2*)(Y + ((size_t)g * HR + rl) * 1024 + colr);
                        s[0] += sigmoidf_(a[0]) * bflo(y.x); s[1] += sigmoidf_(a[1]) * bfhi(y.x); s[2] += sigmoidf_(a[2]) * bflo(y.y); s[3] += sigmoidf_(a[3]) * bfhi(y.y); }
                u32x2 w; w.x = cvt_pk_bf16(s[0], s[1]); w.y = cvt_pk_bf16(s[2], s[3]);
                *(u32x2*)(Mg + (size_t)(rowoff + rl) * 1024 + colr) = w; }
    }
};
}

__device__ __forceinline__ int win_map(int m) {
    if (m < 768) return m;
    if (m < 1888) return m + 4;
    if (m < 2400) return m + 12;
    if (m < 2404) return m - 1632;
    if (m < 2412) return m - 512;
    return -1;
}
template <int job>
__device__ __forceinline__ float wfetch(const KP& p, int l, int n, int k) {
    if constexpr (job == 0 || job == 2) { const int pn = n >> 8, bj = (n >> 7) & 1, c = n & 127; const float* s = (job == 0 ? p.inp(3) : p.inp(28)) + (size_t)l * 1024 * 5632; return s[(size_t)k * 5632 + bj * FF + pn * 128 + c]; }
    else if constexpr (job == 1 || job == 3) { const float* s = (job == 1 ? p.inp(4) : p.inp(29)) + (size_t)l * FF * 1024; return s[(size_t)k * 1024 + n]; }
    else if constexpr (job == 4) { const int o = win_map(n); return o < 0 ? 0.f : p.inp(6)[(size_t)l * 1024 * 2412 + (size_t)k * 2412 + o]; }
    else if constexpr (job == 5) { const int pn = n >> 8, bj = (n >> 7) & 1, wc = (n >> 5) & 3, nn = (n >> 4) & 1, fq = (n >> 2) & 3, j = n & 3; const int g = 2 * bj + nn, col = 64 * pn + 16 * wc + 4 * fq + j;
              return p.inp(23)[((size_t)(l * 4 + g) * 1024 + k) * 1024 + col]; }
    else if constexpr (job == 6) { const int g = n >> 10, col = n & 1023; return p.inp(25)[((size_t)(l * 4 + g) * 256 + k) * 1024 + col]; }
    else if constexpr (job == 7) return p.inp(26)[(size_t)l * 1024 * 1024 + (size_t)k * 1024 + n];
    else {
        if (n < 384) return k < 192 ? p.inp(9)[(size_t)l * 192 * 384 + (size_t)k * 384 + n] : 0.f;
        if (n < 896) return (k >= 192 && k < 320) ? p.inp(11)[(size_t)l * 128 * 512 + (size_t)(k - 192) * 512 + (n - 384)] : 0.f;
        return 0.f; }
}
template <int job>
__device__ __forceinline__ void prep_job(const KP& p, LAS unsigned char* lds, int rot) {
    constexpr int jNp[9] = {5632, 1024, 5632, 1024, 2560, 4096, 4096, 1024, 1024};
    constexpr int jKp[9] = {1024, 2816, 1024, 2816, 1024, 1024, 256, 1024, 384};
    constexpr size_t jOff[9] = {W_WI1, W_WO1, W_WI2, W_WO2, W_WIN, W_WG, W_WB, W_WOUT, W_WUP};
    constexpr int Np = jNp[job], Kp = jKp[job], nkt = Kp / 64, cnt = (Np / 64) * nkt;
    const int tid = otid(), G = ogdim();
    LAS float* tile = (LAS float*)lds;
    for (int it = (obid() + rot) % G; it < 2 * cnt; it += G) {
        const int l = it / cnt, rr = it % cnt;
        const int n0 = (rr / nkt) * 64, k0 = (rr % nkt) * 64;
        const int nn = tid & 63, kk0 = tid >> 6;
#pragma unroll
        for (int i = 0; i < 8; ++i) { const int kk = kk0 + 8 * i; tile[kk * 65 + nn] = wfetch<job>(p, l, n0 + nn, k0 + kk); }
        __syncthreads();
        { const int n2 = tid >> 3, kg = tid & 7; float v[8];
#pragma unroll
          for (int e = 0; e < 8; ++e) v[e] = tile[(kg * 8 + e) * 65 + n2];
          u32x4 w; w.x = cvt_pk_bf16(v[0], v[1]); w.y = cvt_pk_bf16(v[2], v[3]); w.z = cvt_pk_bf16(v[4], v[5]); w.w = cvt_pk_bf16(v[6], v[7]);
          bf16_t* dst = (bf16_t*)(p.ws + OFF_W + (size_t)l * W_LAYER + jOff[job]);
          *(u32x4*)(dst + (size_t)(n0 + n2) * Kp + k0 + kg * 8) = w; }
        __syncthreads();
    }
}
__device__ __forceinline__ void phase_prep(const KP& p, LAS unsigned char* lds) {
    const int tid = otid();
    prep_job<0>(p, lds, 0); prep_job<1>(p, lds, 0); prep_job<2>(p, lds, 0); prep_job<3>(p, lds, 128); prep_job<4>(p, lds, 0);
    prep_job<5>(p, lds, 0); prep_job<6>(p, lds, 0); prep_job<7>(p, lds, 0); prep_job<8>(p, lds, 64);
    float* rope = (float*)(p.ws + OFF_ROPE);
    for (int i = obid() * NTHR + tid; i < TT * 16; i += ogdim() * NTHR) {
        const int t = i >> 4, f = i & 15;
        const float inv = powf(10000.0f, -(float)f * (1.0f / 16.0f));
        const float ang = (float)(t - PADL) * inv;
        rope[i] = cosf(ang); rope[TT * 16 + i] = sinf(ang);
    }
}

__device__ __forceinline__ void phase_rmsnorm(const KP& p, const float* g, int mode) {
    const int tid = otid(), wid = tid >> 6, lane = tid & 63;
    float* H = (float*)(p.ws + OFF_H); bf16_t* UN = (bf16_t*)(p.ws + OFF_UN);
    f32x4 gv[4];
#pragma unroll
    for (int i = 0; i < 4; ++i) gv[i] = *(const f32x4*)(g + i * 256 + lane * 4);
    for (int row = obid() * 8 + wid; row < NT; row += ogdim() * 8) {
        const int b = row / TT, t = row % TT;
        if (mode == 3 && t < 128) continue;
        f32x4 v[4];
        if (mode == 2) {
            const float* src = t < PADL ? nullptr : (t < 128 ? p.inp(1) + (size_t)(t - PADL) * DM : p.inp(0) + ((size_t)b * 4096 + (t - 128)) * DM);
#pragma unroll
            for (int i = 0; i < 4; ++i) { v[i] = src ? *(const f32x4*)(src + i * 256 + lane * 4) : (f32x4){0.f, 0.f, 0.f, 0.f}; *(f32x4*)(H + (size_t)row * DM + i * 256 + lane * 4) = v[i]; }
        } else {
#pragma unroll
            for (int i = 0; i < 4; ++i) v[i] = *(const f32x4*)(H + (size_t)row * DM + i * 256 + lane * 4);
        }
        float ss = 0.f;
#pragma unroll
        for (int i = 0; i < 4; ++i) ss += v[i][0] * v[i][0] + v[i][1] * v[i][1] + v[i][2] * v[i][2] + v[i][3] * v[i][3];
        ss = wave_sum(ss);
        float rstd = rsqrtf(ss * (1.0f / DM) + EPS);
        if (mode == 1 && t < PADL) rstd = 0.f;
        if (mode == 3) {
            float* o = (float*)p.out + ((size_t)b * 4096 + (t - 128)) * DM;
#pragma unroll
            for (int i = 0; i < 4; ++i) *(f32x4*)(o + i * 256 + lane * 4) = v[i] * rstd * gv[i];
        } else {
#pragma unroll
            for (int i = 0; i < 4; ++i) { const f32x4 y = v[i] * rstd * gv[i]; u32x2 w; w.x = cvt_pk_bf16(y[0], y[1]); w.y = cvt_pk_bf16(y[2], y[3]);
                *(u32x2*)(UN + (size_t)row * DM + i * 256 + lane * 4) = w; }
        }
    }
}

__device__ __forceinline__ void phase_mla_pre(const KP& p, int l) {
    const int tid = otid(), wid = tid >> 6, lane = tid & 63;
    const bf16_t* P = (const bf16_t*)(p.ws + OFF_BIG); bf16_t* A = (bf16_t*)(p.ws + OFF_AMLA); bf16_t* Km = (bf16_t*)(p.ws + OFF_KM);
    const float* rope = (const float*)(p.ws + OFF_ROPE);
    const float* gq = p.inp(8) + l * 192; const float* gkv = p.inp(10) + l * 128;
    const float gq0 = gq[lane], gq1 = gq[lane + 64], gq2 = gq[lane + 128], gk0 = gkv[lane], gk1 = gkv[lane + 64];
    for (int row = obid() * 8 + wid; row < NT; row += ogdim() * 8) {
        const bf16_t* pr = P + (size_t)row * PN; const int t = row % TT;
        const float c0 = bf2f(pr[PC_CQ + lane]), c1 = bf2f(pr[PC_CQ + 64 + lane]), c2 = bf2f(pr[PC_CQ + 128 + lane]);
        const float k0 = bf2f(pr[PC_CKV + lane]), k1 = bf2f(pr[PC_CKV + 64 + lane]);
        const float sq = wave_sum(c0 * c0 + c1 * c1 + c2 * c2), sk = wave_sum(k0 * k0 + k1 * k1);
        const float rq = rsqrtf(sq * (1.0f / 192.0f) + EPS), rk = rsqrtf(sk * (1.0f / 128.0f) + EPS);
        bf16_t* ar = A + (size_t)row * 384;
        ar[lane] = f2bf(c0 * rq * gq0); ar[lane + 64] = f2bf(c1 * rq * gq1); ar[lane + 128] = f2bf(c2 * rq * gq2);
        ar[192 + lane] = f2bf(k0 * rk * gk0); ar[256 + lane] = f2bf(k1 * rk * gk1); ar[320 + lane] = 0;
        if (lane < 16) {
            const float x1 = bf2f(pr[PC_KR + lane]), x2 = bf2f(pr[PC_KR + 16 + lane]);
            const float cs = rope[t * 16 + lane], sn = rope[TT * 16 + t * 16 + lane];
            const bf16_t o1 = f2bf(x1 * cs - x2 * sn), o2 = f2bf(x2 * cs + x1 * sn);
            bf16_t* kr = Km + (size_t)row * 384;
#pragma unroll
            for (int hh = 0; hh < 4; ++hh) { kr[hh * 96 + 64 + lane] = o1; kr[hh * 96 + 80 + lane] = o2; }
        }
    }
}
__device__ __forceinline__ void phase_fox_cum(const KP& p, int l) {
    const int tid = otid(), wid = tid >> 6, lane = tid & 63;
    const int gw = obid() * 8 + wid;
    if (gw >= NB * 4) return;
    const int b = gw >> 2, h = gw & 3;
    const bf16_t* P = (const bf16_t*)(p.ws + OFF_BIG); float* cum = (float*)(p.ws + OFF_CUM) + (size_t)gw * TT;
    const float bf = p.inp(7)[l * 4 + h];
    float carry = 0.f;
    for (int t0 = 0; t0 < TT; t0 += 64) {
        const int t = t0 + lane;
        float v = 0.f;
        if (t >= PADL) { const float x = bf2f(P[((size_t)b * TT + t) * PN + PC_FF + h]) + bf; v = fminf(x, 0.f) - log1pf(expf(-fabsf(x))); }
#pragma unroll
        for (int o = 1; o < 64; o <<= 1) { const float u = __shfl_up(v, o); if (lane >= o) v += u; }
        v += carry;
        cum[t] = v * LOG2E;
        carry = __shfl(v, 63);
    }
}

constexpr int GS = 72;
template <bool SWAP>
__device__ __forceinline__ f32x4 mma_nt(const LAS bf16_t* A, const LAS bf16_t* B, int ti, int tj, int lane, f32x4 acc) {
    const int fr = lane & 15, fq = lane >> 4;
#pragma unroll
    for (int ks = 0; ks < 2; ++ks) {
        const bf16x8 a = *(const LAS bf16x8*)(A + (ti * 16 + fr) * GS + ks * 32 + fq * 8);
        const bf16x8 b = *(const LAS bf16x8*)(B + (tj * 16 + fr) * GS + ks * 32 + fq * 8);
        acc = SWAP ? __builtin_amdgcn_mfma_f32_16x16x32_bf16(b, a, acc, 0, 0, 0) : __builtin_amdgcn_mfma_f32_16x16x32_bf16(a, b, acc, 0, 0, 0);
    }
    return acc;
}

__device__ __forceinline__ void lru_item(const KP& p, int l, LAS unsigned char* lds, int item) {
    const int tid = otid(), wid = tid >> 6, lane = tid & 63, j = tid & 63, tq = tid >> 6, fr = lane & 15, fq = lane >> 4;
    const int b = item >> 2, n = item & 3, c = n * 64 + j;
    const bf16_t* P = (const bf16_t*)(p.ws + OFF_BIG) + (size_t)b * TT * PN + PC_LRU + c;
    bf16_t* YS = (bf16_t*)(p.out + OO_YS) + (size_t)b * TT * 1024 + 768 + n * 64;
    LAS float* xs = (LAS float*)lds;
    LAS float* as = xs + 4096;
    LAS float* bs = as + 4096;
    LAS bf16_t* Xb = (LAS bf16_t*)(bs + 4096);
    LAS bf16_t* WaT = Xb + 64 * GS;
    LAS bf16_t* WxT = WaT + 64 * GS;
    const float* cw = p.inp(16) + (size_t)l * 4 * 256;
    const float w0 = cw[c], w1 = cw[256 + c], w2 = cw[512 + c], w3 = cw[768 + c], cb = p.inp(17)[l * 256 + c];
    __syncthreads();
    { const float* WA = p.inp(18) + ((size_t)(l * 4 + n)) * 4096; const float* WX = p.inp(20) + ((size_t)(l * 4 + n)) * 4096;
      for (int e = tid; e < 4096; e += NTHR) { const int i = e >> 6, jj = e & 63; WaT[jj * GS + i] = f2bf(WA[e]); WxT[jj * GS + i] = f2bf(WX[e]); } }
    for (int e = tid; e < 64 * 64; e += NTHR) YS[(size_t)(e >> 6) * 1024 + (e & 63)] = 0;
    float gba[2], gbx[2], gc[2];
#pragma unroll
    for (int q = 0; q < 2; ++q) { const int ch = n * 64 + ((wid * 2 + q) & 3) * 16 + fr;
        gba[q] = p.inp(19)[l * 256 + ch]; gbx[q] = p.inp(21)[l * 256 + ch]; gc[q] = -8.0f * log1pf(expf(-p.inp(22)[l * 256 + ch])); }
    float hst = 0.f;
    bf16_t xr_[11];
#define LRU_LOAD(t0_) do { const int tb_ = (t0_) + tq * 8; _Pragma("unroll") for (int e = 0; e < 11; ++e) xr_[e] = P[(size_t)(tb_ - 3 + e) * PN]; } while (0)
    LRU_LOAD(64);
    for (int t0 = 64; t0 < TT; t0 += 64) {
        {
            float x[11];
#pragma unroll
            for (int e = 0; e < 11; ++e) x[e] = bf2f(xr_[e]);
#pragma unroll
            for (int e = 0; e < 8; ++e) { float xr = cb + w0 * x[e] + w1 * x[e + 1] + w2 * x[e + 2] + w3 * x[e + 3]; if (t0 + tq * 8 + e < PADL) xr = 0.f;
                xs[(tq * 8 + e) * 64 + j] = xr; Xb[(tq * 8 + e) * GS + j] = f2bf(xr); }
        }
        if (t0 + 64 < TT) LRU_LOAD(t0 + 64);
        __syncthreads();
#pragma unroll
        for (int q = 0; q < 2; ++q) { const int tile = wid * 2 + q, ti = tile >> 2, tj = tile & 3;
            const f32x4 ca = mma_nt<false>(Xb, WaT, ti, tj, lane, (f32x4){0.f, 0.f, 0.f, 0.f});
            const f32x4 cx = mma_nt<false>(Xb, WxT, ti, tj, lane, (f32x4){0.f, 0.f, 0.f, 0.f});
#pragma unroll
            for (int e = 0; e < 4; ++e) { const int idx = (ti * 16 + 4 * fq + e) * 64 + tj * 16 + fr;
                const float r = sigmoidf_(ca[e] + gba[q]), ig = sigmoidf_(cx[e] + gbx[q]);
                const float la = gc[q] * r, x2 = 2.0f * la;
                const float om = (x2 > -0.25f) ? -x2 * (1.0f + x2 * (0.5f + x2 * (0.16666667f + x2 * (0.041666668f + x2 * (0.0083333338f + x2 * 0.0013888889f))))) : 1.0f - __expf(x2);
                as[idx] = __expf(la); bs[idx] = __builtin_sqrtf(om) * ig * xs[idx]; }
        }
        __syncthreads();
        if (wid == 0) {
#pragma unroll 8
            for (int t = 0; t < 64; ++t) { hst = as[t * 64 + lane] * hst + bs[t * 64 + lane]; YS[(size_t)(t0 + t) * 1024 + lane] = f2bf(hst); }
        }
    }
#undef LRU_LOAD
    __syncthreads();
}

__device__ __forceinline__ void gdn_gates_v(float araw, float braw, float A, float dtb, int lane, LAS float* betas, LAS float* Gs) {
    const float z = araw + dtb; const float spz = fmaxf(z, 0.f) + log1pf(expf(-fabsf(z)));
    float g = -A * spz;
#pragma unroll
    for (int o = 1; o < 64; o <<= 1) { const float u = __shfl_up(g, o); if (lane >= o) g += u; }
    betas[lane] = 1.0f / (1.0f + expf(-braw)); Gs[lane] = g;
}

__device__ __forceinline__ void gdn_pre_pair(const KP& p, int l, LAS unsigned char* lds, int pair) {
    const int tid = otid(), hf = tid >> 8, lt = tid & 255, wl = lt >> 6, lane = tid & 63, fr = lane & 15, fq = lane >> 4;
    const int cid = pair * 2 + hf, n = cid % 66, bh = cid / 66, b = bh >> 2, h = bh & 3, t0 = n * 64;
    const bool act = n != 0;
    bf16_t* GW = (bf16_t*)(p.out + OO_GW) + (size_t)cid * 4096; bf16_t* GU = (bf16_t*)(p.out + OO_GU) + (size_t)cid * 4096;
    LAS float* Kf = (LAS float*)(lds + hf * 61440);
    LAS float* Vf = Kf + 4096;
    LAS float* Mm = Vf + 4096;
    LAS float* betas = Mm + 4096; LAS float* Gs = betas + 64;
    LAS bf16_t* Kc = (LAS bf16_t*)(Gs + 64);
    const bf16_t* Pb = (const bf16_t*)(p.ws + OFF_BIG) + (size_t)b * TT * PN;
    const float* cw = p.inp(12) + (size_t)l * 4 * 768;
    __syncthreads();
    if (act) {
        const int ch = lt & 63, tq = lt >> 6, tb = t0 + tq * 16;
#pragma unroll
        for (int kv = 0; kv < 2; ++kv) {
            const bf16_t* P = Pb + (kv ? PC_GV : PC_GK) + h * 64 + ch; const float* w = cw + (kv ? 512 : 256) + h * 64 + ch; LAS float* dst = kv ? Vf : Kf;
            const float w0 = w[0], w1 = w[768], w2 = w[1536], w3 = w[2304];
            float x[19];
#pragma unroll
            for (int e = 0; e < 19; ++e) x[e] = bf2f(P[(size_t)(tb - 3 + e) * PN]);
#pragma unroll
            for (int e = 0; e < 16; ++e) dst[(tq * 16 + e) * 64 + ch] = siluf_(w0 * x[e] + w1 * x[e + 1] + w2 * x[e + 2] + w3 * x[e + 3]);
        }
        if (wl == 0) { const bf16_t* pr = Pb + (size_t)(t0 + lane) * PN;
            gdn_gates_v(bf2f(pr[PC_GA + h]), bf2f(pr[PC_GB + h]), expf(p.inp(13)[l * 4 + h]), p.inp(14)[l * 4 + h], lane, betas, Gs); }
    }
    __syncthreads();
    if (act) {
        const int row = lt >> 2, seg = lt & 3; float v[16]; float ss = 0.f;
#pragma unroll
        for (int e = 0; e < 16; ++e) { v[e] = Kf[row * 64 + seg * 16 + e]; ss += v[e] * v[e]; }
        ss += __shfl_xor(ss, 1); ss += __shfl_xor(ss, 2);
        const float rs = rsqrtf(ss + EPS);
#pragma unroll
        for (int e = 0; e < 16; ++e) { v[e] *= rs; Kf[row * 64 + seg * 16 + e] = v[e]; }
#pragma unroll
        for (int q = 0; q < 2; ++q) { u32x4 w; w.x = cvt_pk_bf16(v[8 * q], v[8 * q + 1]); w.y = cvt_pk_bf16(v[8 * q + 2], v[8 * q + 3]); w.z = cvt_pk_bf16(v[8 * q + 4], v[8 * q + 5]); w.w = cvt_pk_bf16(v[8 * q + 6], v[8 * q + 7]);
            *(LAS u32x4*)(Kc + row * GS + seg * 16 + q * 8) = w; }
    }
    __syncthreads();
    if (act) {
#pragma unroll
        for (int q = 0; q < 4; ++q) { const int tile = wl * 4 + q, ti = tile >> 2, tj = tile & 3;
            const f32x4 d = mma_nt<false>(Kc, Kc, ti, tj, lane, (f32x4){0.f, 0.f, 0.f, 0.f});
            const int i = tj * 16 + fr, j0 = ti * 16 + 4 * fq; const float bi = betas[i], gi = Gs[i];
            f32x4 o;
#pragma unroll
            for (int e = 0; e < 4; ++e) { const int jj = j0 + e; o[e] = (i > jj) ? bi * d[e] * __expf(gi - Gs[jj]) : 0.f; }
            *(LAS f32x4*)(Mm + i * 64 + j0) = o; }
    }
    __syncthreads();
    if (act && lt < 128) {
        const int col = lt & 63; const bool isw = lt < 64;
        float s[64];
#pragma unroll
        for (int i = 0; i < 64; ++i) {
            const float bi = betas[i];
            float r = isw ? Kf[i * 64 + col] * bi * __expf(Gs[i]) : Vf[i * 64 + col] * bi;
#pragma unroll
            for (int j4 = 0; j4 < (i + 3) / 4; ++j4) { const f32x4 mv = *(const LAS f32x4*)(Mm + i * 64 + j4 * 4);
#pragma unroll
                for (int e = 0; e < 4; ++e) if (j4 * 4 + e < i) r -= mv[e] * s[j4 * 4 + e]; }
            s[i] = r;
            if (isw) GW[i * 64 + col] = f2bf(r);
        }
        if (!isw) {
#pragma unroll
            for (int q = 0; q < 8; ++q) { u32x4 w; w.x = cvt_pk_bf16(s[q * 8], s[q * 8 + 1]); w.y = cvt_pk_bf16(s[q * 8 + 2], s[q * 8 + 3]); w.z = cvt_pk_bf16(s[q * 8 + 4], s[q * 8 + 5]); w.w = cvt_pk_bf16(s[q * 8 + 6], s[q * 8 + 7]);
                *(u32x4*)(GU + col * 64 + q * 8) = w; }
        }
    }
}

__device__ __forceinline__ void gdn_scan_item(const KP& p, int l, LAS unsigned char* lds, int bh) {
    const int tid = otid(), wid = tid >> 6, lane = tid & 63, fr = lane & 15, fq = lane >> 4;
    const int b = bh >> 2, h = bh & 3;
    LAS float* Qf = (LAS float*)lds;
    LAS float* Kf = Qf + 4096;
    LAS float* betas = Kf + 4096; LAS float* Gs = betas + 64;
    LAS bf16_t* Qc = (LAS bf16_t*)(Gs + 64);
    LAS bf16_t* Kc = Qc + 64 * GS; LAS bf16_t* QD = Kc + 64 * GS; LAS bf16_t* KDT = QD + 64 * GS; LAS bf16_t* QK = KDT + 64 * GS;
    LAS bf16_t* Wc = QK + 64 * GS; LAS bf16_t* ST = Wc + 64 * GS; LAS bf16_t* VNT = ST + 64 * GS; LAS bf16_t* UT = VNT + 64 * GS;
    const bf16_t* Pb = (const bf16_t*)(p.ws + OFF_BIG) + (size_t)b * TT * PN;
    const float* cw = p.inp(12) + (size_t)l * 4 * 768;
    bf16_t* YS = (bf16_t*)(p.out + OO_YS) + (size_t)b * TT * 1024 + 512 + h * 64;
    const float* gon = p.inp(15) + l * 64;
    const int ch = tid & 63, tq = tid >> 6, row = tid >> 3, seg = tid & 7;
    const float wq0 = cw[h * 64 + ch], wq1 = cw[768 + h * 64 + ch], wq2 = cw[1536 + h * 64 + ch], wq3 = cw[2304 + h * 64 + ch];
    const float wk0 = cw[256 + h * 64 + ch], wk1 = cw[768 + 256 + h * 64 + ch], wk2 = cw[1536 + 256 + h * 64 + ch], wk3 = cw[2304 + 256 + h * 64 + ch];
    const float Adec = expf(p.inp(13)[l * 4 + h]), dtb = p.inp(14)[l * 4 + h];
    const bf16_t* Pq = Pb + PC_GQ + h * 64 + ch; const bf16_t* Pk = Pb + PC_GK + h * 64 + ch;
    const bf16_t* GWb = (const bf16_t*)(p.out + OO_GW) + (size_t)bh * 66 * 4096 + row * 64 + seg * 8;
    const bf16_t* GUb = (const bf16_t*)(p.out + OO_GU) + (size_t)bh * 66 * 4096 + row * 64 + seg * 8;
    __syncthreads();
    for (int e = tid; e < 64 * GS / 2; e += NTHR) ((LAS unsigned*)ST)[e] = 0u;
    for (int e = tid; e < 64 * 16; e += NTHR) *(u32x2*)(YS + (size_t)(e >> 4) * 1024 + (e & 15) * 4) = (u32x2){0u, 0u};
    f32x4 Sacc[2] = {(f32x4){0.f, 0.f, 0.f, 0.f}, (f32x4){0.f, 0.f, 0.f, 0.f}};
    bf16_t xq[11], xk[11]; u32x4 wreg, ureg; bf16_t araw = 0, braw = 0; u32x2 ggn[4], ggc[4];
#pragma unroll
    for (int tv = 0; tv < 4; ++tv) { ggn[tv] = (u32x2){0u, 0u}; ggc[tv] = (u32x2){0u, 0u}; }
#define GDN_LOAD(n_) do { const int t0_ = (n_) * 64, tb_ = t0_ + tq * 8; \
        _Pragma("unroll") for (int e = 0; e < 11; ++e) { xq[e] = Pq[(size_t)(tb_ - 3 + e) * PN]; xk[e] = Pk[(size_t)(tb_ - 3 + e) * PN]; } \
        wreg = *(const u32x4*)(GWb + (size_t)(n_) * 4096); ureg = *(const u32x4*)(GUb + (size_t)(n_) * 4096); \
        if (wid == 0) { const bf16_t* pr_ = Pb + (size_t)(t0_ + lane) * PN; araw = pr_[PC_GA + h]; braw = pr_[PC_GB + h]; } \
        if (wid < 4) { const bf16_t* gp_ = Pb + (size_t)(t0_ + wid * 16 + fr) * PN + PC_GG + h * 64 + 4 * fq; \
            _Pragma("unroll") for (int tv = 0; tv < 4; ++tv) ggn[tv] = *(const u32x2*)(gp_ + tv * 16); } } while (0)
    GDN_LOAD(1);
    for (int n = 1; n < 66; ++n) {
        const int t0 = n * 64;
        {
            float x[11];
#pragma unroll
            for (int e = 0; e < 11; ++e) x[e] = bf2f(xq[e]);
#pragma unroll
            for (int e = 0; e < 8; ++e) Qf[(tq * 8 + e) * 64 + ch] = siluf_(wq0 * x[e] + wq1 * x[e + 1] + wq2 * x[e + 2] + wq3 * x[e + 3]);
#pragma unroll
            for (int e = 0; e < 11; ++e) x[e] = bf2f(xk[e]);
#pragma unroll
            for (int e = 0; e < 8; ++e) Kf[(tq * 8 + e) * 64 + ch] = siluf_(wk0 * x[e] + wk1 * x[e + 1] + wk2 * x[e + 2] + wk3 * x[e + 3]);
            if (wid == 0) gdn_gates_v(bf2f(araw), bf2f(braw), Adec, dtb, lane, betas, Gs);
            *(LAS u32x4*)(Wc + row * GS + seg * 8) = wreg; *(LAS u32x4*)(UT + row * GS + seg * 8) = ureg;
#pragma unroll
            for (int tv = 0; tv < 4; ++tv) ggc[tv] = ggn[tv];
        }
        if (n + 1 < 66) GDN_LOAD(n + 1);
        __syncthreads();
        {
            float q[8], k[8]; float sq = 0.f, sk = 0.f;
#pragma unroll
            for (int e = 0; e < 8; ++e) { q[e] = Qf[row * 64 + seg * 8 + e]; k[e] = Kf[row * 64 + seg * 8 + e]; sq += q[e] * q[e]; sk += k[e] * k[e]; }
            sq += __shfl_xor(sq, 1); sq += __shfl_xor(sq, 2); sq += __shfl_xor(sq, 4);
            sk += __shfl_xor(sk, 1); sk += __shfl_xor(sk, 2); sk += __shfl_xor(sk, 4);
            const float rq = rsqrtf(sq + EPS) * 0.125f, rk = rsqrtf(sk + EPS);
            const float g = Gs[row], eg = __expf(g), ekd = __expf(Gs[63] - g);
#pragma unroll
            for (int e = 0; e < 8; ++e) { q[e] *= rq; k[e] *= rk; }
            u32x4 w; w.x = cvt_pk_bf16(q[0], q[1]); w.y = cvt_pk_bf16(q[2], q[3]); w.z = cvt_pk_bf16(q[4], q[5]); w.w = cvt_pk_bf16(q[6], q[7]);
            *(LAS u32x4*)(Qc + row * GS + seg * 8) = w;
            w.x = cvt_pk_bf16(q[0] * eg, q[1] * eg); w.y = cvt_pk_bf16(q[2] * eg, q[3] * eg); w.z = cvt_pk_bf16(q[4] * eg, q[5] * eg); w.w = cvt_pk_bf16(q[6] * eg, q[7] * eg);
            *(LAS u32x4*)(QD + row * GS + seg * 8) = w;
            w.x = cvt_pk_bf16(k[0], k[1]); w.y = cvt_pk_bf16(k[2], k[3]); w.z = cvt_pk_bf16(k[4], k[5]); w.w = cvt_pk_bf16(k[6], k[7]);
            *(LAS u32x4*)(Kc + row * GS + seg * 8) = w;
#pragma unroll
            for (int e = 0; e < 8; ++e) KDT[(seg * 8 + e) * GS + row] = f2bf(k[e] * ekd);
        }
        __syncthreads();
        {
#pragma unroll
            for (int q = 0; q < 2; ++q) { const int tile = wid * 2 + q, ti = tile >> 2, tj = tile & 3;
                const f32x4 d = mma_nt<true>(Qc, Kc, ti, tj, lane, (f32x4){0.f, 0.f, 0.f, 0.f});
                const int i = ti * 16 + fr, j0 = tj * 16 + 4 * fq; const float gi = Gs[i];
                float o[4];
#pragma unroll
                for (int e = 0; e < 4; ++e) { const int jj = j0 + e; o[e] = (i >= jj) ? d[e] * __expf(gi - Gs[jj]) : 0.f; }
                u32x2 w; w.x = cvt_pk_bf16(o[0], o[1]); w.y = cvt_pk_bf16(o[2], o[3]);
                *(LAS u32x2*)(QK + i * GS + j0) = w; }
#pragma unroll
            for (int q = 0; q < 2; ++q) { const int tile = wid * 2 + q, ti = tile >> 2, tj = tile & 3;
                const f32x4 d = mma_nt<false>(Wc, ST, ti, tj, lane, (f32x4){0.f, 0.f, 0.f, 0.f});
                const int dv = tj * 16 + fr, c0 = ti * 16 + 4 * fq;
                const u32x2 uu = *(const LAS u32x2*)(UT + dv * GS + c0);
                u32x2 w; w.x = cvt_pk_bf16(bflo(uu.x) - d[0], bfhi(uu.x) - d[1]); w.y = cvt_pk_bf16(bflo(uu.y) - d[2], bfhi(uu.y) - d[3]);
                *(LAS u32x2*)(VNT + dv * GS + c0) = w; }
        }
        __syncthreads();
        {
            const float gl = __expf(Gs[63]);
            if (wid < 4) {
                f32x4 o[4];
#pragma unroll
                for (int tv = 0; tv < 4; ++tv) { o[tv] = mma_nt<true>(QD, ST, wid, tv, lane, (f32x4){0.f, 0.f, 0.f, 0.f}); o[tv] = mma_nt<true>(QK, VNT, wid, tv, lane, o[tv]); }
                float ss = 0.f;
#pragma unroll
                for (int tv = 0; tv < 4; ++tv) ss += o[tv][0] * o[tv][0] + o[tv][1] * o[tv][1] + o[tv][2] * o[tv][2] + o[tv][3] * o[tv][3];
                ss += __shfl_xor(ss, 16); ss += __shfl_xor(ss, 32);
                const float rs = rsqrtf(ss * (1.0f / 64.0f) + EPS);
                const int t = t0 + wid * 16 + fr;
#pragma unroll
                for (int tv = 0; tv < 4; ++tv) { const int dv = tv * 16 + 4 * fq;
                    const u32x2 gg = ggc[tv]; const f32x4 gn = *(const f32x4*)(gon + dv);
                    u32x2 w; w.x = cvt_pk_bf16(o[tv][0] * rs * gn[0] * siluf_(bflo(gg.x)), o[tv][1] * rs * gn[1] * siluf_(bfhi(gg.x)));
                    w.y = cvt_pk_bf16(o[tv][2] * rs * gn[2] * siluf_(bflo(gg.y)), o[tv][3] * rs * gn[3] * siluf_(bfhi(gg.y)));
                    if (t < PADL) { w.x = 0u; w.y = 0u; }
                    *(u32x2*)(YS + (size_t)t * 1024 + dv) = w; }
            }
#pragma unroll
            for (int q = 0; q < 2; ++q) { const int tile = wid * 2 + q, ti = tile >> 2, tj = tile & 3;
                Sacc[q] = mma_nt<false>(KDT, VNT, ti, tj, lane, Sacc[q] * gl); }
        }
        __syncthreads();
#pragma unroll
        for (int q = 0; q < 2; ++q) { const int tile = wid * 2 + q, ti = tile >> 2, tj = tile & 3;
            u32x2 w; w.x = cvt_pk_bf16(Sacc[q][0], Sacc[q][1]); w.y = cvt_pk_bf16(Sacc[q][2], Sacc[q][3]);
            *(LAS u32x2*)(ST + (tj * 16 + fr) * GS + ti * 16 + 4 * fq) = w; }
    }
#undef GDN_LOAD
    __syncthreads();
}

template <int DK, bool FOX>
__device__ __forceinline__ void attn_item(LAS unsigned char* lds, const bf16_t* Qp, int ldq, const bf16_t* Kp, int ldk, const bf16_t* Vp, int ldv,
                          const float* cum2, const float* rope, float c1, bf16_t* Op, int qt) {
    constexpr int KST = DK + 8, NDS = DK / 16, KPIECES = 64 * DK / 8;
    const int tid = otid(), wid = tid >> 6, lane = tid & 63, qi = lane & 31, half = lane >> 5;
    LAS bf16_t* Ks = (LAS bf16_t*)lds;
    LAS bf16_t* Vt = Ks + 64 * KST;
    LAS float* Cs = (LAS float*)(Vt + 64 * 72);
    const int q0 = qt * 256 + wid * 32, tq = q0 + qi;
    const bool wact = q0 < TT;
    bf16x8 qf[NDS];
#pragma unroll
    for (int ds = 0; ds < NDS; ++ds) qf[ds] = (tq < TT) ? *(const bf16x8*)(Qp + (size_t)tq * ldq + ds * 16 + 8 * half) : (bf16x8){0, 0, 0, 0, 0, 0, 0, 0};
    if (!FOX) {
        const int tr = tq < TT ? tq : TT - 1;
        const float* cs = rope + tr * 16 + 8 * half; const float* sn = rope + TT * 16 + tr * 16 + 8 * half;
        u32x4 a = *(u32x4*)&qf[NDS - 2], b = *(u32x4*)&qf[NDS - 1];
        unsigned aw[4] = {a.x, a.y, a.z, a.w}, bw[4] = {b.x, b.y, b.z, b.w};
#pragma unroll
        for (int e = 0; e < 4; ++e) { const float c0 = cs[2 * e], c1_ = cs[2 * e + 1], s0_ = sn[2 * e], s1_ = sn[2 * e + 1];
            const float x1l = bflo(aw[e]), x1h = bfhi(aw[e]), x2l = bflo(bw[e]), x2h = bfhi(bw[e]);
            aw[e] = cvt_pk_bf16(x1l * c0 - x2l * s0_, x1h * c1_ - x2h * s1_); bw[e] = cvt_pk_bf16(x2l * c0 + x1l * s0_, x2h * c1_ + x1h * s1_); }
        a = (u32x4){aw[0], aw[1], aw[2], aw[3]}; b = (u32x4){bw[0], bw[1], bw[2], bw[3]};
        qf[NDS - 2] = *(bf16x8*)&a; qf[NDS - 1] = *(bf16x8*)&b;
    }
    const float cq = FOX ? cum2[tq < TT ? tq : TT - 1] : 0.f;
    f32x16 o0, o1;
#pragma unroll
    for (int r = 0; r < 16; ++r) { o0[r] = 0.f; o1[r] = 0.f; }
    float mrow = -1e30f, lrow = 0.f;
    const int jmax = (4 * qt + 3) < 65 ? (4 * qt + 3) : 65;
    const int jw = (q0 + 31) >> 6;
    u32x4 kr0, kr1, vr; float cr = 0.f;
    const int kkey0 = tid / (DK / 8), kseg0 = tid % (DK / 8), kkey1 = (tid + 512) / (DK / 8), kseg1 = (tid + 512) % (DK / 8);
    const int vkey = tid >> 3, vseg = tid & 7;
    const int vpos = (vkey & ~15) + 8 * ((vkey >> 2) & 1) + 4 * ((vkey >> 3) & 1) + (vkey & 3);
#define ATT_PREFETCH(j) do { const size_t kb_ = (size_t)(j) * 64; \
        kr0 = *(const u32x4*)(Kp + (kb_ + kkey0) * ldk + kseg0 * 8); \
        if (KPIECES > 512 && tid + 512 < KPIECES) kr1 = *(const u32x4*)(Kp + (kb_ + kkey1) * ldk + kseg1 * 8); \
        vr = *(const u32x4*)(Vp + (kb_ + vkey) * ldv + vseg * 8); \
        if (FOX && tid < 64) cr = cum2[kb_ + tid]; } while (0)
    kr1 = (u32x4){0u, 0u, 0u, 0u};
    ATT_PREFETCH(1);
    for (int j = 1; j <= jmax; ++j) {
        __syncthreads();
        *(LAS u32x4*)(Ks + kkey0 * KST + kseg0 * 8) = kr0;
        if (KPIECES > 512 && tid + 512 < KPIECES) *(LAS u32x4*)(Ks + kkey1 * KST + kseg1 * 8) = kr1;
        {
            const unsigned w[4] = {vr.x, vr.y, vr.z, vr.w};
#pragma unroll
            for (int e = 0; e < 4; ++e) { Vt[(vseg * 8 + 2 * e) * 72 + vpos] = (bf16_t)(w[e] & 0xffffu); Vt[(vseg * 8 + 2 * e + 1) * 72 + vpos] = (bf16_t)(w[e] >> 16); }
        }
        if (FOX && tid < 64) Cs[tid] = cr;
        __syncthreads();
        if (j + 1 <= jmax) ATT_PREFETCH(j + 1);
        if (wact && j <= jw) {
            f32x16 s0, s1;
#pragma unroll
            for (int r = 0; r < 16; ++r) { s0[r] = 0.f; s1[r] = 0.f; }
#pragma unroll
            for (int ds = 0; ds < NDS; ++ds) {
                const bf16x8 a0 = *(const LAS bf16x8*)(Ks + qi * KST + ds * 16 + 8 * half);
                const bf16x8 a1 = *(const LAS bf16x8*)(Ks + (32 + qi) * KST + ds * 16 + 8 * half);
                s0 = __builtin_amdgcn_mfma_f32_32x32x16_bf16(a0, qf[ds], s0, 0, 0, 0);
                s1 = __builtin_amdgcn_mfma_f32_32x32x16_bf16(a1, qf[ds], s1, 0, 0, 0);
            }
            const bool need_mask = (j == 1) || (j * 64 + 63 > q0);
            float mx = -1e30f;
#pragma unroll
            for (int g = 0; g < 4; ++g) {
                f32x4 c0v = (f32x4){0.f, 0.f, 0.f, 0.f}, c1v = c0v;
                if (FOX) { c0v = *(const LAS f32x4*)(Cs + g * 8 + half * 4); c1v = *(const LAS f32x4*)(Cs + 32 + g * 8 + half * 4); }
#pragma unroll
                for (int e = 0; e < 4; ++e) { const int r = g * 4 + e; const int kl = g * 8 + half * 4 + e;
                    float x0 = s0[r] * c1, x1 = s1[r] * c1;
                    if (FOX) { x0 += cq - c0v[e]; x1 += cq - c1v[e]; }
                    if (need_mask) { const int key0 = j * 64 + kl, key1 = key0 + 32;
                        if (key0 < PADL || key0 > tq) x0 = -1e30f;
                        if (key1 < PADL || key1 > tq) x1 = -1e30f; }
                    s0[r] = x0; s1[r] = x1; mx = fmaxf(mx, fmaxf(x0, x1)); }
            }
            mx = fmaxf(mx, __shfl_xor(mx, 32));
            const float mnew = fmaxf(mrow, mx), alpha = exp2f(mrow - mnew);
            float rs = 0.f;
#pragma unroll
            for (int r = 0; r < 16; ++r) { s0[r] = exp2f(s0[r] - mnew); s1[r] = exp2f(s1[r] - mnew); rs += s0[r] + s1[r]; }
            rs += __shfl_xor(rs, 32);
            lrow = lrow * alpha + rs; mrow = mnew;
#pragma unroll
            for (int r = 0; r < 16; ++r) { o0[r] *= alpha; o1[r] *= alpha; }
#pragma unroll
            for (int s = 0; s < 4; ++s) {
                bf16x8 pf;
                {
                    unsigned w[4];
#pragma unroll
                    for (int e = 0; e < 4; ++e) { const int r = 8 * (s & 1) + 2 * e; w[e] = (s < 2) ? cvt_pk_bf16(s0[r], s0[r + 1]) : cvt_pk_bf16(s1[r], s1[r + 1]); }
                    u32x4 ww = (u32x4){w[0], w[1], w[2], w[3]}; pf = *(bf16x8*)&ww;
                }
                const bf16x8 v0 = *(const LAS bf16x8*)(Vt + qi * 72 + 16 * s + 8 * half);
                const bf16x8 v1 = *(const LAS bf16x8*)(Vt + (32 + qi) * 72 + 16 * s + 8 * half);
                o0 = __builtin_amdgcn_mfma_f32_32x32x16_bf16(v0, pf, o0, 0, 0, 0);
                o1 = __builtin_amdgcn_mfma_f32_32x32x16_bf16(v1, pf, o1, 0, 0, 0);
            }
        }
    }
#undef ATT_PREFETCH
    if (tq < TT) {
        const float inv = (tq >= PADL && lrow > 0.f) ? 1.0f / lrow : 0.f;
        bf16_t* orow = Op + (size_t)tq * 1024;
#pragma unroll
        for (int g = 0; g < 4; ++g) {
            u32x2 w; w.x = cvt_pk_bf16(o0[4 * g] * inv, o0[4 * g + 1] * inv); w.y = cvt_pk_bf16(o0[4 * g + 2] * inv, o0[4 * g + 3] * inv);
            *(u32x2*)(orow + 8 * g + 4 * half) = w;
            w.x = cvt_pk_bf16(o1[4 * g] * inv, o1[4 * g + 1] * inv); w.y = cvt_pk_bf16(o1[4 * g + 2] * inv, o1[4 * g + 3] * inv);
            *(u32x2*)(orow + 32 + 8 * g + 4 * half) = w;
        }
    }
}
__device__ __forceinline__ void phase_attn(const KP& p, LAS unsigned char* lds, int vb, int nvb, int kinds) {
    const bf16_t* P = (const bf16_t*)(p.ws + OFF_BIG);
    const bf16_t* Qm = (const bf16_t*)(p.ws + OFF_QM); const bf16_t* Km = (const bf16_t*)(p.ws + OFF_KM); const bf16_t* Vm = (const bf16_t*)(p.out + OO_VM);
    const float* cum = (const float*)(p.ws + OFF_CUM);
    bf16_t* YS = (bf16_t*)(p.out + OO_YS);
    const int per = (kinds == 3) ? 128 : 64, nitems = 17 * per;
    for (int rnd = 0;; ++rnd) {
        const int idx = rnd * nvb + ((rnd & 1) ? (nvb - 1 - vb) : vb);
        if (rnd * nvb >= nitems) break;
        if (idx >= nitems) continue;
        const int qt = 16 - idx / per; const int rem = idx % per;
        int kind, bh;
        if (kinds == 3) { kind = rem & 1; bh = rem >> 1; } else { kind = (kinds == 2); bh = rem; }
        const int b = bh >> 2, h = bh & 3;
        if (kind == 0)
            attn_item<64, true>(lds, P + (size_t)b * TT * PN + PC_FQ + h * 64, PN, P + (size_t)b * TT * PN + PC_FK + h * 64, PN, P + (size_t)b * TT * PN + PC_FV + h * 64, PN,
                                cum + (size_t)bh * TT, nullptr, 0.125f * LOG2E, YS + (size_t)b * TT * 1024 + h * 64, qt);
        else
            attn_item<96, false>(lds, Qm + (size_t)b * TT * 384 + h * 96, 384, Km + (size_t)b * TT * 384 + h * 96, 384, Vm + (size_t)b * TT * 256 + h * 64, 256,
                                 nullptr, (const float*)(p.ws + OFF_ROPE), 0.10206207261596577f * LOG2E, YS + (size_t)b * TT * 1024 + 256 + h * 64, qt);
    }
    __syncthreads();
}

constexpr int NPL = 16, NPH = 2 + 2 * NPL;

template <int ph>
__device__ __forceinline__ void run_phase(const KP& p, LAS unsigned char* lds) {
    const int G = ogdim(), c = obid();
    char* ws = p.ws;
    int kind = -1, l = 0;
    int s = -1;
    if (ph == 0) { if (EN_MASK & 1) phase_prep(p, lds); return; }
    if (ph == NPH - 1) { phase_rmsnorm(p, p.inp(30), 3); return; }
    l = (ph - 1) / NPL; s = (ph - 1) % NPL;
    const char* W = ws + OFF_W + (size_t)l * W_LAYER;
    pg8::Sched S;
    const void* gA = nullptr; const void* gB = nullptr; int gK = 0, lda = 0, ldb = 0, half = 0; float alpha = 0.f;
    switch (s) {
    case 0: phase_rmsnorm(p, p.inp(2) + l * DM, l == 0 ? 2 : 0); return;
    case 3: phase_rmsnorm(p, p.inp(5) + l * DM, 1); return;
    case 13: phase_rmsnorm(p, p.inp(27) + l * DM, 0); return;
    case 1: kind = 0; gA = ws + OFF_UN; gB = W + W_WI1; break;
    case 14: kind = 0; gA = ws + OFF_UN; gB = W + W_WI2; break;
    case 2: kind = 1; gA = ws + OFF_BIG; gB = W + W_WO1; gK = FF; lda = FF; ldb = FF; alpha = 0.5f; break;
    case 15: kind = 1; gA = ws + OFF_BIG; gB = W + W_WO2; gK = FF; lda = FF; ldb = FF; alpha = 0.5f; break;
    case 12: kind = 1; gA = ws + OFF_MERGED; gB = W + W_WOUT; gK = DM; lda = DM; ldb = DM; alpha = 1.0f; break;
    case 4: kind = 2; break;
    case 5: {
        phase_mla_pre(p, l);
        phase_fox_cum(p, l);
        if (c < 64) { if (EN_MASK & 2) lru_item(p, l, lds, c); }
        else if (EN_MASK & 4) for (int pr = c - 64; pr < NB * 4 * 33; pr += G - 64) gdn_pre_pair(p, l, lds, pr);
        return; }
    case 6: kind = 3; break;
    case 7: if (EN_MASK & 8) phase_attn(p, lds, c, G, 2); return;
    case 8: kind = 4; half = 0; break;
    case 10: kind = 4; half = 1; break;
    case 9: kind = 5; half = 0; break;
    case 11: kind = 5; half = 1; break;
    default: return;
    }
    if (!(EN_MASK & 32)) return;
    if (!((GK_MASK >> kind) & 1)) return;
    switch (kind) {
    case 0: if ((GK_MASK >> 0) & 1) { S.init(NT / 256, 2 * FF / 256, G, c, 0, gA, DM, gB, DM); pg8::EpiSwiglu E{(bf16_t*)(ws + OFF_BIG)}; pg8::gemm_phase(lds, DM, DM, DM, S, E); break; }
    case 1: if ((GK_MASK >> 1) & 1) { S.init(NT / 256, DM / 256, G, c, 0, gA, lda, gB, ldb); pg8::EpiResid E{(float*)(ws + OFF_H), alpha}; pg8::gemm_phase(lds, gK, lda, ldb, S, E); break; }
    case 2: if ((GK_MASK >> 2) & 1) { S.init(NT / 256, PN / 256, G, c, 0, ws + OFF_UN, DM, W + W_WIN, DM); pg8::EpiBf16 E{(bf16_t*)(ws + OFF_BIG), PN, 0}; pg8::gemm_phase(lds, DM, DM, DM, S, E); break; }
    case 3: if ((GK_MASK >> 3) & 1) {
              if (c < 64) { if (EN_MASK & 16) gdn_scan_item(p, l, lds, c); }
              else { S.init(NT / 256, 4, G - 64, c - 64, 0, ws + OFF_AMLA, 384, W + W_WUP, 384);
                  pg8::EpiMlaUp E{(bf16_t*)(ws + OFF_QM), (bf16_t*)(ws + OFF_KM), (bf16_t*)(p.out + OO_VM)}; pg8::gemm_phase(lds, 384, 384, 384, S, E);
                  __syncthreads();
                  if (EN_MASK & 8) phase_attn(p, lds, c - 64, G - 64, 1); }
              break; }
    case 4: if ((GK_MASK >> 4) & 1) { S.init(HR / 256, 16, G, c, 1, p.out + OO_YS + (size_t)half * HR * 1024 * 2, 1024, W + W_WB, 256);
              pg8::EpiBf16 E{(bf16_t*)(ws + OFF_BIG), 1024, 1}; pg8::gemm_phase(lds, 256, 1024, 256, S, E); break; }
    case 5: if ((GK_MASK >> 5) & 1) { S.init(HR / 256, 16, G, c, 0, ws + OFF_UN + (size_t)half * HR * DM * 2, DM, W + W_WG, DM);
              pg8::EpiGate E{(bf16_t*)(ws + OFF_MERGED), (const bf16_t*)(ws + OFF_BIG), p.inp(24) + (size_t)l * 4 * DM, half * HR}; pg8::gemm_phase(lds, DM, DM, DM, S, E); break; }
    default: break;
    }
}

template <int PH>
__device__ __forceinline__ void run_all(const KP& p, LAS unsigned char* lds) {
    if constexpr (PH < NPH) {
        run_phase<PH>(p, lds);
        if constexpr (PH >= 1 && PH < NPH - 1 && ((REP_MASK >> ((PH - 1) % NPL)) & 1)) { cg::this_grid().sync(); run_phase<PH>(p, lds); }
        if constexpr (PH + 1 < NPH) cg::this_grid().sync();
        run_all<PH + 1>(p, lds);
    }
}
__global__ void __launch_bounds__(NTHR, 2) mega_kernel(KPA pa) {
    extern __shared__ __attribute__((aligned(16))) unsigned char smem[];
    LAS unsigned char* lds = (LAS unsigned char*)smem;
    KP p;
#pragma unroll
    for (int i = 0; i < 31; ++i) p.in[i] = pa.in[i];
    p.ws = pa.ws; p.out = pa.out; p.lo = 0; p.hi = 0;
    run_all<0>(p, lds);
}

extern "C" void kernel_launch(void* const* d_in, const int* in_sizes, int n_in, void* d_out, int out_size, void* d_ws, size_t ws_size, hipStream_t stream) {
    static int grid = 0;
    if (grid == 0) {
        if (n_in != 31 || ws_size < WS_END) { fprintf(stderr, "kernel_launch: unexpected n_in %d / ws %zu (need %zu)\n", n_in, ws_size, (size_t)WS_END); grid = -1; return; }
        int dev = 0, cus = 0, per_cu = 0;
        hipGetDevice(&dev); hipDeviceGetAttribute(&cus, hipDeviceAttributeMultiprocessorCount, dev);
        if (hipFuncSetAttribute((const void*)mega_kernel, hipFuncAttributeMaxDynamicSharedMemorySize, LDS_BYTES) != hipSuccess) { fprintf(stderr, "kernel_launch: hipFuncSetAttribute failed\n"); grid = -1; return; }
        if (hipOccupancyMaxActiveBlocksPerMultiprocessor(&per_cu, (const void*)mega_kernel, NTHR, LDS_BYTES) != hipSuccess || per_cu < 1) { fprintf(stderr, "kernel_launch: occupancy query says %d\n", per_cu); per_cu = 1; }
        (void)hipGetLastError();
        grid = cus;
    }
    if (grid < 0) return;
    KPA a; memset(&a, 0, sizeof(a));
    for (int i = 0; i < 31; ++i) a.in[i] = (const float*)d_in[i];
    a.ws = (char*)d_ws; a.out = (char*)d_out;
    a.lo = 0; a.hi = NPH;
    void* args[] = {&a};
    hipError_t e = hipLaunchCooperativeKernel((const void*)mega_kernel, dim3(grid), dim3(NTHR), args, LDS_BYTES, stream);
    if (e != hipSuccess) fprintf(stderr, "cooperative launch failed: %s (grid %d)\n", hipGetErrorString(e), grid);
}
```

```cpp
#include <hip/hip_runtime.h>
#include <hip/hip_cooperative_groups.h>
#include <cstdio>
#include <cstring>
namespace cg = cooperative_groups;

#ifndef SUBREP
#define SUBREP 0
#endif
#ifndef REP_MASK
#define REP_MASK 0
#endif
#ifndef GK_MASK
#define GK_MASK 0xff
#endif
#ifndef EN_MASK
#define EN_MASK 0xff
#endif
#ifndef ONE_LAUNCH
#define ONE_LAUNCH 1
#endif

#define LAS __attribute__((address_space(3)))
typedef unsigned short bf16_t;
typedef short bf16x8 __attribute__((ext_vector_type(8)));
typedef float f32x4 __attribute__((ext_vector_type(4)));
typedef float f32x16 __attribute__((ext_vector_type(16)));
typedef unsigned u32x4 __attribute__((ext_vector_type(4)));
typedef unsigned u32x2 __attribute__((ext_vector_type(2)));

constexpr int NB = 16, TT = 4224, NT = NB * TT, DM = 1024, FF = 2816, PADL = 112, PN = 2560;
constexpr int HR = NT / 2;
constexpr float EPS = 1e-6f, LOG2E = 1.4426950408889634f;
constexpr int NTHR = 512, LDS_BYTES = 131072;
constexpr int PC_FQ = 0, PC_FK = 256, PC_FV = 512, PC_CQ = 768, PC_CKV = 960, PC_KR = 1088, PC_GQ = 1120, PC_GK = 1376, PC_GV = 1632,
              PC_GG = 1888, PC_LRU = 2144, PC_FF = 2400, PC_GA = 2404, PC_GB = 2408;
constexpr size_t W_WI1 = 0, W_WO1 = W_WI1 + 5632ull * 1024 * 2, W_WI2 = W_WO1 + 1024ull * 2816 * 2, W_WO2 = W_WI2 + 5632ull * 1024 * 2,
                 W_WIN = W_WO2 + 1024ull * 2816 * 2, W_WUP = W_WIN + 2560ull * 1024 * 2, W_WG = W_WUP + 1024ull * 384 * 2,
                 W_WB = W_WG + 4096ull * 1024 * 2, W_WOUT = W_WB + 4096ull * 256 * 2, W_LAYER = W_WOUT + 1024ull * 1024 * 2;
constexpr size_t OFF_H = 0, OFF_W = OFF_H + (size_t)NT * DM * 4, OFF_UN = OFF_W + 2 * W_LAYER, OFF_BIG = OFF_UN + (size_t)NT * DM * 2,
                 OFF_REST = OFF_BIG + (size_t)NT * FF * 2;
constexpr size_t OFF_AMLA = OFF_REST, OFF_QM = OFF_AMLA + (size_t)NT * 384 * 2, OFF_KM = OFF_QM + (size_t)NT * 384 * 2,
                 OFF_CUM = OFF_KM + (size_t)NT * 384 * 2, OFF_ROPE = OFF_CUM + (size_t)NB * 4 * TT * 4, OFF_SS = OFF_ROPE + (size_t)TT * 32 * 4, WS_END = OFF_SS + (size_t)NT * 6 * 8;
constexpr size_t OFF_MERGED = OFF_REST;
constexpr size_t OFF_VTF = OFF_BIG + (size_t)NT * PN * 2;
static_assert(OFF_VTF + (size_t)NT * 256 * 2 <= OFF_REST, "vtf");
static_assert(WS_END <= (1ull << 30), "workspace");
constexpr size_t OO_YS = 0, OO_VM = OO_YS + (size_t)NT * 1024 * 2, OO_GW = OO_VM + (size_t)NT * 256 * 2,
                 OO_GU = OO_GW + (size_t)NB * 4 * 66 * 4096 * 2, OO_END = OO_GU + (size_t)NB * 4 * 66 * 4096 * 2;
static_assert(OO_END <= (size_t)NB * 4096 * 1024 * 4, "out scratch");

struct KP { const float* in[31]; char* ws; char* out; int lo, hi;
    __device__ __forceinline__ const float* inp(int i) const { return in[i]; } };
typedef KP KPA;

__device__ __forceinline__ unsigned cvt_pk_bf16(float lo, float hi) { unsigned r; asm("v_cvt_pk_bf16_f32 %0, %1, %2" : "=v"(r) : "v"(lo), "v"(hi)); return r; }
__device__ __forceinline__ bf16_t f2bf(float f) { return (bf16_t)(cvt_pk_bf16(f, 0.f) & 0xffffu); }
__device__ __forceinline__ float bf2f(bf16_t b) { return __uint_as_float(((unsigned)b) << 16); }
__device__ __forceinline__ float bflo(unsigned w) { return __uint_as_float(w << 16); }
__device__ __forceinline__ float bfhi(unsigned w) { return __uint_as_float(w & 0xffff0000u); }
__device__ __forceinline__ float sigmoidf_(float x) { return __builtin_amdgcn_rcpf(1.0f + __expf(-x)); }
__device__ __forceinline__ float siluf_(float x) { return x * sigmoidf_(x); }
__device__ __forceinline__ int otid() { int t = threadIdx.x; asm volatile("" : "+v"(t)); return t; }
__device__ __forceinline__ int obid() { return (int)blockIdx.x; }
__device__ __forceinline__ int ogdim() { return (int)gridDim.x; }
__device__ __forceinline__ float wave_sum(float v) {
#pragma unroll
    for (int o = 32; o >= 1; o >>= 1) v += __shfl_xor(v, o);
    return v;
}

namespace pg8 {
constexpr int BM = 256, BK = 64, HALF = 128, HTB = HALF * BK * 2, NXCD = 8, WGM = 8;
__device__ __forceinline__ int lds_byte(int r, int c) { const int st = (r >> 4) * 2 + (c >> 5), rr = r & 15, cc = c & 31, ob = rr * 64 + cc * 2; return st * 1024 + (ob ^ (((ob >> 9) & 1) << 5)); }
__device__ __forceinline__ void stage_rc(int b, int& R, int& C) { const int st = b / 1024, sb = b % 1024, swz = sb ^ (((sb >> 9) & 1) << 5); R = (st >> 1) * 16 + swz / 64; C = (st & 1) * 32 + (swz % 64) / 2; }
__device__ __forceinline__ int perm32(int rho) { const int n = rho >> 4, i = rho & 15; return 8 * (i >> 2) + 4 * n + (i & 3); }

__device__ __forceinline__ const char* uptr(const char* p) { const unsigned long long v = (unsigned long long)p;
    const unsigned lo = __builtin_amdgcn_readfirstlane((unsigned)v), hi = __builtin_amdgcn_readfirstlane((unsigned)(v >> 32)); return (const char*)(((unsigned long long)hi << 32) | lo); }
struct Unit { int pm, pn; const char* pa; const char* pb; };
struct Sched {
    int nM, nN, nwg, G, c, mode; const char* A; const char* B; size_t tA, tB;
    __device__ void init(int nM_, int nN_, int G_, int c_, int mode_, const void* A_, int lda, const void* B_, int ldb) {
        nM = nM_; nN = nN_; nwg = nM * nN; G = G_; c = c_; mode = mode_; A = (const char*)A_; B = (const char*)B_; tA = (size_t)BM * lda * 2; tB = (size_t)BM * ldb * 2; }
    __device__ bool next(int i, Unit& u) const {
        const long L = (long)i * G + c; if (L >= nwg) return false;
        int wgid = (int)L; { const int q = nwg / NXCD, r = nwg % NXCD, xcd = wgid % NXCD, off = wgid / NXCD; wgid = (xcd < r ? xcd * (q + 1) : r * (q + 1) + (xcd - r) * q) + off; }
        const int nig = WGM * nN, gid = wgid / nig, fm = gid * WGM, gsz = (nM - fm) < WGM ? (nM - fm) : WGM;
        u.pm = fm + ((wgid % nig) % gsz); u.pn = (wgid % nig) / gsz;
        if (mode == 0) { u.pa = A + (size_t)u.pm * tA; u.pb = B + (size_t)u.pn * tB; }
        else { const int g = u.pn >> 2, q = u.pn & 3; u.pa = A + (size_t)u.pm * tA + (size_t)g * 512; u.pb = B + (size_t)g * (1024ull * 256 * 2) + (size_t)q * tB; }
        return true;
    }
};

template <class Epi>
__device__ __forceinline__ void gemm_phase(LAS unsigned char* lds, int K, int lda, int ldb, const Sched& S, const Epi& E) {
    const int tid = otid(), wid = __builtin_amdgcn_readfirstlane(tid >> 6), lane = tid & 63, wr = wid >> 2, wc = wid & 3, fr = lane & 15, fq = lane >> 4;
    const int nt = K / BK;
    unsigned voffA[2], voffB[2];
#pragma unroll
    for (int i = 0; i < 2; ++i) { int R, C; stage_rc(tid * 16 + i * 8192, R, C); const int Rb = Epi::PERM ? ((R & ~31) + perm32(R & 31)) : R;
        voffA[i] = (unsigned)(R * lda + C) * 2u; voffB[i] = (unsigned)(Rb * ldb + C) * 2u; }
    const size_t kstep = (size_t)(BK * 2);
    const size_t hA = (size_t)HALF * lda * 2, hB = (size_t)HALF * ldb * 2;
    const unsigned ldsw = (unsigned)wid * 1024u;
    const int aoff = lds_byte(wr * 64 + fr, fq * 8), boff = lds_byte(wc * 32 + fr, fq * 8);
#define PG8_SA(b, h) (((b) * 2 + (h)) * HTB)
#define PG8_SB(b, h) ((4 + (b) * 2 + (h)) * HTB)
#define PG8_STAGE(bufoff, gbase, voff) do { const char* _ub = (const char*)(gbase); _Pragma("unroll") for (int _i = 0; _i < 2; ++_i) { unsigned _vo = (voff)[_i]; asm volatile("" : "+v"(_vo)); \
        __builtin_amdgcn_global_load_lds((const unsigned*)(_ub + _vo), (LAS unsigned*)(lds + (bufoff) + ldsw + _i * 8192), 16, 0, 0); } } while (0)
#define PG8_LDA(dst, b, h) do { _Pragma("unroll") for (int m = 0; m < 4; ++m) _Pragma("unroll") for (int k = 0; k < 2; ++k) dst[m][k] = *(const LAS bf16x8*)(lds + PG8_SA(b, h) + aoff + m * 2048 + k * 1024); } while (0)
#define PG8_LDB(dst, b, h) do { _Pragma("unroll") for (int n = 0; n < 2; ++n) _Pragma("unroll") for (int k = 0; k < 2; ++k) dst[n][k] = *(const LAS bf16x8*)(lds + PG8_SB(b, h) + boff + n * 2048 + k * 1024); } while (0)
#define PG8_MMA(ai, bj, At, Bt) do { __builtin_amdgcn_s_setprio(1); _Pragma("unroll") for (int m = 0; m < 4; ++m) _Pragma("unroll") for (int n = 0; n < 2; ++n) _Pragma("unroll") for (int k = 0; k < 2; ++k) \
        acc[ai][bj][m][n] = __builtin_amdgcn_mfma_f32_16x16x32_bf16(Bt[n][k], At[m][k], acc[ai][bj][m][n], 0, 0, 0); __builtin_amdgcn_s_setprio(0); } while (0)
#define PG8_WAIT_V(n) asm volatile("s_waitcnt vmcnt(" #n ")" ::: "memory")
#define PG8_WAIT_L(n) asm volatile("s_waitcnt lgkmcnt(" #n ")" ::: "memory")
#define PG8_BAR __builtin_amdgcn_s_barrier()
#define PG8_SCHED __builtin_amdgcn_sched_barrier(0)
    Unit cur, nxt; int ui = 0;
    if (!S.next(0, cur)) return;
    f32x4 acc[2][2][4][2];
#pragma unroll
    for (int a = 0; a < 2; ++a)
#pragma unroll
        for (int b = 0; b < 2; ++b)
#pragma unroll
            for (int m = 0; m < 4; ++m)
#pragma unroll
                for (int n = 0; n < 2; ++n) acc[a][b][m][n] = (f32x4){0.f, 0.f, 0.f, 0.f};
    bf16x8 At[4][2], B0[2][2], B1[2][2];
    const char* cA = cur.pa; const char* cB = cur.pb;
    PG8_STAGE(PG8_SB(0, 0), cB, voffB); PG8_STAGE(PG8_SA(0, 0), cA, voffA); PG8_STAGE(PG8_SB(0, 1), cB + hB, voffB); PG8_STAGE(PG8_SA(0, 1), cA + hA, voffA);
    if (wr == 1) PG8_BAR;
    PG8_WAIT_V(4); PG8_BAR;
    PG8_STAGE(PG8_SB(1, 0), cB + kstep, voffB); PG8_STAGE(PG8_SA(1, 0), cA + kstep, voffA); PG8_STAGE(PG8_SB(1, 1), cB + hB + kstep, voffB);
    PG8_WAIT_V(6); PG8_BAR;
    for (;;) {
        const bool has_next = S.next(ui + 1, nxt);
        const char* nA = has_next ? nxt.pa : cA; const char* nB = has_next ? nxt.pb : cB;
        for (int t = 0; t < nt; t += 2) {
            const bool last = (t == nt - 2);
            const char* a1 = cA + (size_t)(t + 1) * kstep;
            const char* a2 = last ? nA : cA + (size_t)(t + 2) * kstep; const char* b2 = last ? nB : cB + (size_t)(t + 2) * kstep;
            const char* a3 = a2 + kstep; const char* b3 = b2 + kstep;
            PG8_LDB(B0, 0, 0); PG8_SCHED; PG8_LDA(At, 0, 0); PG8_STAGE(PG8_SA(1, 1), a1 + hA, voffA);
            PG8_WAIT_L(8); PG8_BAR; PG8_WAIT_L(0); PG8_MMA(0, 0, At, B0); PG8_BAR; PG8_SCHED;
            PG8_LDB(B1, 0, 1); PG8_STAGE(PG8_SB(0, 0), b2, voffB);
            PG8_BAR; PG8_WAIT_L(0); PG8_MMA(0, 1, At, B1); PG8_BAR;
            PG8_LDA(At, 0, 1); PG8_STAGE(PG8_SA(0, 0), a2, voffA);
            PG8_BAR; PG8_WAIT_L(0); PG8_MMA(1, 0, At, B0); PG8_BAR; PG8_SCHED;
            PG8_STAGE(PG8_SB(0, 1), b2 + hB, voffB);
            PG8_WAIT_V(6); PG8_BAR; PG8_MMA(1, 1, At, B1); PG8_BAR;
            PG8_LDB(B0, 1, 0); PG8_SCHED; PG8_LDA(At, 1, 0); PG8_STAGE(PG8_SA(0, 1), a2 + hA, voffA);
            PG8_WAIT_L(8); PG8_BAR; PG8_WAIT_L(0); PG8_MMA(0, 0, At, B0); PG8_BAR; PG8_SCHED;
            PG8_LDB(B1, 1, 1); PG8_STAGE(PG8_SB(1, 0), b3, voffB);
            PG8_BAR; PG8_WAIT_L(0); PG8_MMA(0, 1, At, B1); PG8_BAR;
            PG8_LDA(At, 1, 1); PG8_STAGE(PG8_SA(1, 0), a3, voffA);
            PG8_BAR; PG8_WAIT_L(0); PG8_MMA(1, 0, At, B0); PG8_BAR; PG8_SCHED;
            PG8_STAGE(PG8_SB(1, 1), b3 + hB, voffB);
            PG8_WAIT_V(6); PG8_BAR; PG8_MMA(1, 1, At, B1); PG8_BAR;
        }
        E(acc, cur, wr, wc, fr, fq);
        if (!has_next) break;
#pragma unroll
        for (int a = 0; a < 2; ++a)
#pragma unroll
            for (int b = 0; b < 2; ++b)
#pragma unroll
                for (int m = 0; m < 4; ++m)
#pragma unroll
                    for (int n = 0; n < 2; ++n) acc[a][b][m][n] = (f32x4){0.f, 0.f, 0.f, 0.f};
        cur = nxt; cA = nA; cB = nB; ++ui;
    }
    PG8_WAIT_V(0);
    if (wr == 0) PG8_BAR;
    PG8_BAR;
#undef PG8_SA
#undef PG8_SB
#undef PG8_STAGE
#undef PG8_LDA
#undef PG8_LDB
#undef PG8_MMA
#undef PG8_WAIT_V
#undef PG8_WAIT_L
#undef PG8_BAR
#undef PG8_SCHED
}

typedef f32x4 Acc[2][2][4][2];
typedef unsigned long long ssq_t;
__device__ __forceinline__ float rstd_of(ssq_t q) { return rsqrtf((float)q * (1.0f / (1048576.0f * DM)) + EPS); }
__device__ __forceinline__ ssq_t ssq_fix(float sq) { return (ssq_t)(sq * 1048576.0f + 0.5f); }
struct EpiSwiglu {
    static constexpr bool PERM = true;
    bf16_t* O; const ssq_t* SS;
    __device__ __forceinline__ void operator()(const Acc& acc, const Unit& u, int wr, int wc, int fr, int fq) const {
        const int row0 = u.pm * BM + wr * 64 + fr, col0 = u.pn * 128 + wc * 32 + 8 * fq;
        ssq_t ssv[8];
#pragma unroll
        for (int i = 0; i < 8; ++i) ssv[i] = SS[row0 + (i >> 2) * HALF + (i & 3) * 16];
#pragma unroll
        for (int ai = 0; ai < 2; ++ai)
#pragma unroll
            for (int m = 0; m < 4; ++m) {
                const int r = row0 + ai * HALF + m * 16; const float rs = rstd_of(ssv[ai * 4 + m]);
                const f32x4 g0 = acc[ai][0][m][0] * rs, g1 = acc[ai][0][m][1] * rs, u0 = acc[ai][1][m][0] * rs, u1 = acc[ai][1][m][1] * rs;
                u32x4 w;
                w.x = cvt_pk_bf16(siluf_(g0[0]) * u0[0], siluf_(g0[1]) * u0[1]); w.y = cvt_pk_bf16(siluf_(g0[2]) * u0[2], siluf_(g0[3]) * u0[3]);
                w.z = cvt_pk_bf16(siluf_(g1[0]) * u1[0], siluf_(g1[1]) * u1[1]); w.w = cvt_pk_bf16(siluf_(g1[2]) * u1[2], siluf_(g1[3]) * u1[3]);
                *(u32x4*)(O + (size_t)r * FF + col0) = w;
            }
    }
};
struct EpiResid {
    static constexpr bool PERM = false;
    float* H; float alpha; bf16_t* HB; ssq_t* SS;
    __device__ __forceinline__ void operator()(const Acc& acc, const Unit& u, int wr, int wc, int fr, int fq) const {
        const int row0 = u.pm * BM + wr * 64 + fr, col0 = u.pn * BM + wc * 32 + 4 * fq;
#pragma unroll
        for (int ai = 0; ai < 2; ++ai) {
            f32x4 hv[4][2][2];
#pragma unroll
            for (int m = 0; m < 4; ++m) { const float* rowp = H + (size_t)(row0 + ai * HALF + m * 16) * DM + col0;
#pragma unroll
                for (int bj = 0; bj < 2; ++bj)
#pragma unroll
                    for (int n = 0; n < 2; ++n) hv[m][bj][n] = *(const f32x4*)(rowp + bj * HALF + n * 16); }
#pragma unroll
            for (int m = 0; m < 4; ++m) { const size_t r = (size_t)(row0 + ai * HALF + m * 16); float* rowp = H + r * DM + col0; bf16_t* hbp = HB + r * DM + col0; float sq = 0.f;
#pragma unroll
                for (int bj = 0; bj < 2; ++bj)
#pragma unroll
                    for (int n = 0; n < 2; ++n) { const f32x4 v = hv[m][bj][n] + acc[ai][bj][m][n] * alpha; *(f32x4*)(rowp + bj * HALF + n * 16) = v;
                        sq += (v[0] * v[0] + v[1] * v[1]) + (v[2] * v[2] + v[3] * v[3]);
                        u32x2 w; w.x = cvt_pk_bf16(v[0], v[1]); w.y = cvt_pk_bf16(v[2], v[3]); *(u32x2*)(hbp + bj * HALF + n * 16) = w; }
                sq += __shfl_xor(sq, 16); sq += __shfl_xor(sq, 32);
                if (fq == 0) __hip_atomic_fetch_add(SS + r, ssq_fix(sq), __ATOMIC_RELAXED, __HIP_MEMORY_SCOPE_AGENT); }
        }
    }
};
struct EpiBf16 {
    static constexpr bool PERM = true;
    bf16_t* O; int ldc; int ymode; bf16_t* vt; const ssq_t* SS;
    __device__ __forceinline__ void operator()(const Acc& acc, const Unit& u, int wr, int wc, int fr, int fq) const {
        const int row0 = u.pm * BM + wr * 64 + fr;
        if (vt != nullptr && u.pn == 2) {
#pragma unroll
            for (int ai = 0; ai < 2; ++ai)
#pragma unroll
                for (int m = 0; m < 4; ++m) { const int r = row0 + ai * HALF + m * 16; const int b = r / TT, t = r - b * TT;
                    const int pt = (t & ~15) + 8 * ((t >> 2) & 1) + 4 * ((t >> 3) & 1) + (t & 3); const float rs = rstd_of(SS[r]);
#pragma unroll
                    for (int bj = 0; bj < 2; ++bj) { const int c = bj * HALF + wc * 32 + 8 * fq; bf16_t* dst = vt + ((size_t)(b * 4 + (c >> 6)) * 64 + (c & 63)) * TT + pt;
#pragma unroll
                        for (int n = 0; n < 2; ++n)
#pragma unroll
                            for (int e = 0; e < 4; ++e) dst[(size_t)(4 * n + e) * TT] = f2bf(acc[ai][bj][m][n][e] * rs); } }
            return;
        }
        bf16_t* base = O; int colt = u.pn * BM;
        if (ymode) { base += (size_t)(u.pn >> 2) * HR * 1024; colt = (u.pn & 3) * BM; }
        const int col0 = colt + wc * 32 + 8 * fq;
        ssq_t ssv[8];
#pragma unroll
        for (int i = 0; i < 8; ++i) ssv[i] = SS ? SS[row0 + (i >> 2) * HALF + (i & 3) * 16] : 0ull;
#pragma unroll
        for (int ai = 0; ai < 2; ++ai)
#pragma unroll
            for (int m = 0; m < 4; ++m) { const int r = row0 + ai * HALF + m * 16; bf16_t* rowp = base + (size_t)r * ldc + col0; const float rs = SS ? rstd_of(ssv[ai * 4 + m]) : 1.0f;
#pragma unroll
                for (int bj = 0; bj < 2; ++bj) { const f32x4 v0 = acc[ai][bj][m][0] * rs, v1 = acc[ai][bj][m][1] * rs;
                    u32x4 w; w.x = cvt_pk_bf16(v0[0], v0[1]); w.y = cvt_pk_bf16(v0[2], v0[3]); w.z = cvt_pk_bf16(v1[0], v1[1]); w.w = cvt_pk_bf16(v1[2], v1[3]);
                    *(u32x4*)(rowp + bj * HALF) = w; } }
    }
};
struct EpiMlaUp {
    static constexpr bool PERM = false;
    bf16_t* Qm; bf16_t* Km; bf16_t* Vm;
    __device__ __forceinline__ void operator()(const Acc& acc, const Unit& u, int wr, int wc, int fr, int fq) const {
        const int row0 = u.pm * BM + wr * 64 + fr;
#pragma unroll
        for (int bj = 0; bj < 2; ++bj) {
            const int g32 = u.pn * 8 + bj * 4 + wc;
            if (g32 >= 28) continue;
            if (g32 < 12) {
                {
#pragma unroll
                    for (int ai = 0; ai < 2; ++ai)
#pragma unroll
                        for (int m = 0; m < 4; ++m) { const size_t r = (size_t)(row0 + ai * HALF + m * 16);
#pragma unroll
                            for (int n = 0; n < 2; ++n) { const f32x4 v = acc[ai][bj][m][n]; u32x2 w; w.x = cvt_pk_bf16(v[0], v[1]); w.y = cvt_pk_bf16(v[2], v[3]);
                                *(u32x2*)(Qm + r * 384 + g32 * 32 + n * 16 + 4 * fq) = w; } }
                }
            } else {
                const int cc = (g32 - 12) * 32, hh = cc >> 7, w_ = cc & 127;
                if (w_ < 64) {
                    bf16_t* dst = Km + hh * 96 + w_;
#pragma unroll
                    for (int ai = 0; ai < 2; ++ai)
#pragma unroll
                        for (int m = 0; m < 4; ++m) { const size_t r = (size_t)(row0 + ai * HALF + m * 16);
#pragma unroll
                            for (int n = 0; n < 2; ++n) { const f32x4 v = acc[ai][bj][m][n]; u32x2 w; w.x = cvt_pk_bf16(v[0], v[1]); w.y = cvt_pk_bf16(v[2], v[3]);
                                *(u32x2*)(dst + r * 384 + n * 16 + 4 * fq) = w; } }
                } else {
#pragma unroll
                    for (int ai = 0; ai < 2; ++ai)
#pragma unroll
                        for (int m = 0; m < 4; ++m) { const int r = row0 + ai * HALF + m * 16; const int b = r / TT, t = r - b * TT;
                            const int pt = (t & ~15) + 8 * ((t >> 2) & 1) + 4 * ((t >> 3) & 1) + (t & 3);
                            bf16_t* dst = Vm + ((size_t)(b * 4 + hh) * 64 + (w_ - 64) + 4 * fq) * TT + pt;
#pragma unroll
                            for (int n = 0; n < 2; ++n)
#pragma unroll
                                for (int e = 0; e < 4; ++e) dst[(size_t)(16 * n + e) * TT] = f2bf(acc[ai][bj][m][n][e]); }
                }
            }
        }
    }
};
struct EpiGate {
    static constexpr bool PERM = false;
    bf16_t* Mg; const bf16_t* Y; const float* bg; int rowoff; const ssq_t* SS;
    __device__ __forceinline__ void operator()(const Acc& acc, const Unit& u, int wr, int wc, int fr, int fq) const {
        const int row0 = u.pm * BM + wr * 64 + fr, colr = u.pn * 64 + wc * 16 + 4 * fq;
        f32x4 bv[4];
#pragma unroll
        for (int g = 0; g < 4; ++g) bv[g] = *(const f32x4*)(bg + g * 1024 + colr);
        ssq_t ssv[8];
#pragma unroll
        for (int i = 0; i < 8; ++i) ssv[i] = SS[rowoff + row0 + (i >> 2) * HALF + (i & 3) * 16];
#pragma unroll
        for (int ai = 0; ai < 2; ++ai) {
            u32x2 yv[4][4];
#pragma unroll
            for (int m = 0; m < 4; ++m)
#pragma unroll
                for (int g = 0; g < 4; ++g) yv[m][g] = *(const u32x2*)(Y + ((size_t)g * HR + row0 + ai * HALF + m * 16) * 1024 + colr);
#pragma unroll
            for (int m = 0; m < 4; ++m) { const int rl = row0 + ai * HALF + m * 16; const float rs = rstd_of(ssv[ai * 4 + m]);
                f32x4 s = (f32x4){0.f, 0.f, 0.f, 0.f};
#pragma unroll
                for (int bj = 0; bj < 2; ++bj)
#pragma unroll
                    for (int n = 0; n < 2; ++n) { const int g = 2 * bj + n; const f32x4 a = acc[ai][bj][m][n] * rs + bv[g];
                        const u32x2 y = yv[m][g];
                        s[0] += sigmoidf_(a[0]) * bflo(y.x); s[1] += sigmoidf_(a[1]) * bfhi(y.x); s[2] += sigmoidf_(a[2]) * bflo(y.y); s[3] += sigmoidf_(a[3]) * bfhi(y.y); }
                u32x2 w; w.x = cvt_pk_bf16(s[0], s[1]); w.y = cvt_pk_bf16(s[2], s[3]);
                *(u32x2*)(Mg + (size_t)(rowoff + rl) * 1024 + colr) = w; }
        }
    }
};
}

__device__ __forceinline__ int win_map(int m) {
    if (m < 768) return m;
    if (m < 1888) return m + 4;
    if (m < 2400) return m + 12;
    if (m < 2404) return m - 1632;
    if (m < 2412) return m - 512;
    return -1;
}
template <int job>
__device__ __forceinline__ float wfetch(const KP& p, int l, int n, int k) {
    if constexpr (job == 0 || job == 2) { const int pn = n >> 8, bj = (n >> 7) & 1, c = n & 127; const float* s = (job == 0 ? p.inp(3) : p.inp(28)) + (size_t)l * 1024 * 5632; return s[(size_t)k * 5632 + bj * FF + pn * 128 + c] * (job == 0 ? p.inp(2) : p.inp(27))[l * DM + k]; }
    else if constexpr (job == 1 || job == 3) { const float* s = (job == 1 ? p.inp(4) : p.inp(29)) + (size_t)l * FF * 1024; return s[(size_t)k * 1024 + n]; }
    else if constexpr (job == 4) { const int o = win_map(n); return o < 0 ? 0.f : p.inp(6)[(size_t)l * 1024 * 2412 + (size_t)k * 2412 + o] * p.inp(5)[l * DM + k]; }
    else if constexpr (job == 5) { const int pn = n >> 8, bj = (n >> 7) & 1, wc = (n >> 5) & 3, nn = (n >> 4) & 1, fq = (n >> 2) & 3, j = n & 3; const int g = 2 * bj + nn, col = 64 * pn + 16 * wc + 4 * fq + j;
              return p.inp(23)[((size_t)(l * 4 + g) * 1024 + k) * 1024 + col] * p.inp(5)[l * DM + k]; }
    else if constexpr (job == 6) { const int g = n >> 10, col = n & 1023; return p.inp(25)[((size_t)(l * 4 + g) * 256 + k) * 1024 + col]; }
    else if constexpr (job == 7) return p.inp(26)[(size_t)l * 1024 * 1024 + (size_t)k * 1024 + n];
    else {
        if (n < 384) return k < 192 ? p.inp(9)[(size_t)l * 192 * 384 + (size_t)k * 384 + n] : 0.f;
        if (n < 896) return (k >= 192 && k < 320) ? p.inp(11)[(size_t)l * 128 * 512 + (size_t)(k - 192) * 512 + (n - 384)] : 0.f;
        return 0.f; }
}
template <int job>
__device__ __forceinline__ void prep_job(const KP& p, LAS unsigned char* lds, int rot) {
    constexpr int jNp[9] = {5632, 1024, 5632, 1024, 2560, 4096, 4096, 1024, 1024};
    constexpr int jKp[9] = {1024, 2816, 1024, 2816, 1024, 1024, 256, 1024, 384};
    constexpr size_t jOff[9] = {W_WI1, W_WO1, W_WI2, W_WO2, W_WIN, W_WG, W_WB, W_WOUT, W_WUP};
    constexpr int Np = jNp[job], Kp = jKp[job], nkt = Kp / 64, cnt = (Np / 64) * nkt;
    const int tid = otid(), G = ogdim();
    LAS float* tile = (LAS float*)lds;
    for (int it = (obid() + rot) % G; it < 2 * cnt; it += G) {
        const int l = it / cnt, rr = it % cnt;
        const int n0 = (rr / nkt) * 64, k0 = (rr % nkt) * 64;
        const int nn = tid & 63, kk0 = tid >> 6;
#pragma unroll
        for (int i = 0; i < 8; ++i) { const int kk = kk0 + 8 * i; tile[kk * 65 + nn] = wfetch<job>(p, l, n0 + nn, k0 + kk); }
        __syncthreads();
        { const int n2 = tid >> 3, kg = tid & 7; float v[8];
#pragma unroll
          for (int e = 0; e < 8; ++e) v[e] = tile[(kg * 8 + e) * 65 + n2];
          u32x4 w; w.x = cvt_pk_bf16(v[0], v[1]); w.y = cvt_pk_bf16(v[2], v[3]); w.z = cvt_pk_bf16(v[4], v[5]); w.w = cvt_pk_bf16(v[6], v[7]);
          bf16_t* dst = (bf16_t*)(p.ws + OFF_W + (size_t)l * W_LAYER + jOff[job]);
          *(u32x4*)(dst + (size_t)(n0 + n2) * Kp + k0 + kg * 8) = w; }
        __syncthreads();
    }
}
__device__ __forceinline__ void phase_prep(const KP& p, LAS unsigned char* lds) {
    const int tid = otid();
    prep_job<0>(p, lds, 0); prep_job<1>(p, lds, 0); prep_job<2>(p, lds, 0); prep_job<3>(p, lds, 128); prep_job<4>(p, lds, 0);
    prep_job<5>(p, lds, 0); prep_job<6>(p, lds, 0); prep_job<7>(p, lds, 0); prep_job<8>(p, lds, 64);
    float* rope = (float*)(p.ws + OFF_ROPE);
    for (int i = obid() * NTHR + tid; i < TT * 16; i += ogdim() * NTHR) {
        const int t = i >> 4, f = i & 15;
        const float inv = powf(10000.0f, -(float)f * (1.0f / 16.0f));
        const float ang = (float)(t - PADL) * inv;
        rope[i] = cosf(ang); rope[TT * 16 + i] = sinf(ang);
    }
}

__device__ __forceinline__ void phase_rmsnorm(const KP& p, const float* g, int mode) {
    const int tid = otid(), wid = tid >> 6, lane = tid & 63;
    float* H = (float*)(p.ws + OFF_H); bf16_t* HB = (bf16_t*)(p.ws + OFF_UN); pg8::ssq_t* SS = (pg8::ssq_t*)(p.ws + OFF_SS);
    f32x4 gv[4];
#pragma unroll
    for (int i = 0; i < 4; ++i) gv[i] = (mode == 3) ? *(const f32x4*)(g + i * 256 + lane * 4) : (f32x4){0.f, 0.f, 0.f, 0.f};
    for (int row = obid() * 8 + wid; row < NT; row += ogdim() * 8) {
        const int b = row / TT, t = row % TT;
        if (mode == 3 && t < 128) continue;
        f32x4 v[4];
        if (mode == 2) {
            const float* src = t < PADL ? nullptr : (t < 128 ? p.inp(1) + (size_t)(t - PADL) * DM : p.inp(0) + ((size_t)b * 4096 + (t - 128)) * DM);
#pragma unroll
            for (int i = 0; i < 4; ++i) { v[i] = src ? *(const f32x4*)(src + i * 256 + lane * 4) : (f32x4){0.f, 0.f, 0.f, 0.f}; *(f32x4*)(H + (size_t)row * DM + i * 256 + lane * 4) = v[i];
                u32x2 w; w.x = cvt_pk_bf16(v[i][0], v[i][1]); w.y = cvt_pk_bf16(v[i][2], v[i][3]); *(u32x2*)(HB + (size_t)row * DM + i * 256 + lane * 4) = w; }
        } else {
#pragma unroll
            for (int i = 0; i < 4; ++i) v[i] = *(const f32x4*)(H + (size_t)row * DM + i * 256 + lane * 4);
        }
        float ss = 0.f;
#pragma unroll
        for (int i = 0; i < 4; ++i) ss += v[i][0] * v[i][0] + v[i][1] * v[i][1] + v[i][2] * v[i][2] + v[i][3] * v[i][3];
        ss = wave_sum(ss);
        if (mode == 2) { if (lane < 6) SS[(size_t)lane * NT + row] = lane == 0 ? pg8::ssq_fix(ss) : 0ull; }
        else {
            const float rstd = rsqrtf(ss * (1.0f / DM) + EPS);
            float* o = (float*)p.out + ((size_t)b * 4096 + (t - 128)) * DM;
#pragma unroll
            for (int i = 0; i < 4; ++i) *(f32x4*)(o + i * 256 + lane * 4) = v[i] * rstd * gv[i];
        }
    }
}

__device__ __forceinline__ void phase_mla_pre(const KP& p, int l) {
    const int tid = otid(), wid = tid >> 6, lane = tid & 63;
    const bf16_t* P = (const bf16_t*)(p.ws + OFF_BIG); bf16_t* A = (bf16_t*)(p.ws + OFF_AMLA); bf16_t* Km = (bf16_t*)(p.ws + OFF_KM);
    const float* rope = (const float*)(p.ws + OFF_ROPE);
    const float* gq = p.inp(8) + l * 192; const float* gkv = p.inp(10) + l * 128;
    const float gq0 = gq[lane], gq1 = gq[lane + 64], gq2 = gq[lane + 128], gk0 = gkv[lane], gk1 = gkv[lane + 64];
    for (int row = obid() * 8 + wid; row < NT; row += ogdim() * 8) {
        const bf16_t* pr = P + (size_t)row * PN; const int t = row % TT;
        const float c0 = bf2f(pr[PC_CQ + lane]), c1 = bf2f(pr[PC_CQ + 64 + lane]), c2 = bf2f(pr[PC_CQ + 128 + lane]);
        const float k0 = bf2f(pr[PC_CKV + lane]), k1 = bf2f(pr[PC_CKV + 64 + lane]);
        const float sq = wave_sum(c0 * c0 + c1 * c1 + c2 * c2), sk = wave_sum(k0 * k0 + k1 * k1);
        const float rq = rsqrtf(sq * (1.0f / 192.0f) + EPS), rk = rsqrtf(sk * (1.0f / 128.0f) + EPS);
        bf16_t* ar = A + (size_t)row * 384;
        ar[lane] = f2bf(c0 * rq * gq0); ar[lane + 64] = f2bf(c1 * rq * gq1); ar[lane + 128] = f2bf(c2 * rq * gq2);
        ar[192 + lane] = f2bf(k0 * rk * gk0); ar[256 + lane] = f2bf(k1 * rk * gk1); ar[320 + lane] = 0;
        if (lane < 16) {
            const float x1 = bf2f(pr[PC_KR + lane]), x2 = bf2f(pr[PC_KR + 16 + lane]);
            const float cs = rope[t * 16 + lane], sn = rope[TT * 16 + t * 16 + lane];
            const bf16_t o1 = f2bf(x1 * cs - x2 * sn), o2 = f2bf(x2 * cs + x1 * sn);
            bf16_t* kr = Km + (size_t)row * 384;
#pragma unroll
            for (int hh = 0; hh < 4; ++hh) { kr[hh * 96 + 64 + lane] = o1; kr[hh * 96 + 80 + lane] = o2; }
        }
    }
}
__device__ __forceinline__ void fox_cum_item(const KP& p, int l, LAS unsigned char* lds, int bh) {
    const int tid = otid(), wid = tid >> 6, lane = tid & 63;
    const int b = bh >> 2, h = bh & 3;
    const bf16_t* P = (const bf16_t*)(p.ws + OFF_BIG) + (size_t)b * TT * PN + PC_FF + h; float* cum = (float*)(p.ws + OFF_CUM) + (size_t)bh * TT;
    const float bf = p.inp(7)[l * 4 + h];
    LAS float* wtot = (LAS float*)lds;
    float v[9]; float run = 0.f;
#pragma unroll
    for (int e = 0; e < 9; ++e) { const int t = tid * 9 + e; float x = 0.f;
        if (t >= PADL && t < TT) { const float z = bf2f(P[(size_t)t * PN]) + bf; x = fminf(z, 0.f) - log1pf(expf(-fabsf(z))); }
        run += x; v[e] = run; }
    float inc = run;
#pragma unroll
    for (int o = 1; o < 64; o <<= 1) { const float u = __shfl_up(inc, o); if (lane >= o) inc += u; }
    __syncthreads();
    if (lane == 63) wtot[wid] = inc;
    __syncthreads();
    float off = inc - run;
#pragma unroll
    for (int w = 0; w < 8; ++w) if (w < wid) off += wtot[w];
#pragma unroll
    for (int e = 0; e < 9; ++e) { const int t = tid * 9 + e; if (t < TT) cum[t] = (off + v[e]) * LOG2E; }
    __syncthreads();
}

constexpr int GS = 72;
template <bool SWAP>
__device__ __forceinline__ f32x4 mma_nt(const LAS bf16_t* A, const LAS bf16_t* B, int ti, int tj, int lane, f32x4 acc) {
    const int fr = lane & 15, fq = lane >> 4;
#pragma unroll
    for (int ks = 0; ks < 2; ++ks) {
        const bf16x8 a = *(const LAS bf16x8*)(A + (ti * 16 + fr) * GS + ks * 32 + fq * 8);
        const bf16x8 b = *(const LAS bf16x8*)(B + (tj * 16 + fr) * GS + ks * 32 + fq * 8);
        acc = SWAP ? __builtin_amdgcn_mfma_f32_16x16x32_bf16(b, a, acc, 0, 0, 0) : __builtin_amdgcn_mfma_f32_16x16x32_bf16(a, b, acc, 0, 0, 0);
    }
    return acc;
}

__device__ __forceinline__ void lru_item(const KP& p, int l, LAS unsigned char* lds, int item) {
    const int tid = otid(), wid = tid >> 6, lane = tid & 63, j = tid & 63, tq = tid >> 6, fr = lane & 15, fq = lane >> 4;
    const int b = item >> 2, n = item & 3, c = n * 64 + j;
    const bf16_t* P = (const bf16_t*)(p.ws + OFF_BIG) + (size_t)b * TT * PN + PC_LRU + c;
    bf16_t* YS = (bf16_t*)(p.out + OO_YS) + (size_t)b * TT * 1024 + 768 + n * 64;
    LAS float* xs = (LAS float*)lds;
    LAS float* as = xs + 4096;
    LAS float* bs = as + 4096;
    LAS bf16_t* Xb = (LAS bf16_t*)(bs + 4096);
    LAS bf16_t* WaT = Xb + 64 * GS;
    LAS bf16_t* WxT = WaT + 64 * GS;
    const float* cw = p.inp(16) + (size_t)l * 4 * 256;
    const float w0 = cw[c], w1 = cw[256 + c], w2 = cw[512 + c], w3 = cw[768 + c], cb = p.inp(17)[l * 256 + c];
    __syncthreads();
    { const float* WA = p.inp(18) + ((size_t)(l * 4 + n)) * 4096; const float* WX = p.inp(20) + ((size_t)(l * 4 + n)) * 4096;
      for (int e = tid; e < 4096; e += NTHR) { const int i = e >> 6, jj = e & 63; WaT[jj * GS + i] = f2bf(WA[e]); WxT[jj * GS + i] = f2bf(WX[e]); } }
    for (int e = tid; e < 64 * 64; e += NTHR) YS[(size_t)(e >> 6) * 1024 + (e & 63)] = 0;
    float gba[2], gbx[2], gc[2];
#pragma unroll
    for (int q = 0; q < 2; ++q) { const int ch = n * 64 + ((wid * 2 + q) & 3) * 16 + fr;
        gba[q] = p.inp(19)[l * 256 + ch]; gbx[q] = p.inp(21)[l * 256 + ch]; gc[q] = -8.0f * log1pf(expf(-p.inp(22)[l * 256 + ch])); }
    float hst = 0.f;
    bf16_t xr_[11];
#define LRU_LOAD(t0_) do { const int tb_ = (t0_) + tq * 8; _Pragma("unroll") for (int e = 0; e < 11; ++e) xr_[e] = P[(size_t)(tb_ - 3 + e) * PN]; } while (0)
    LRU_LOAD(64);
    for (int t0 = 64; t0 < TT; t0 += 64) {
        {
            float x[11];
#pragma unroll
            for (int e = 0; e < 11; ++e) x[e] = bf2f(xr_[e]);
#pragma unroll
            for (int e = 0; e < 8; ++e) { float xr = cb + w0 * x[e] + w1 * x[e + 1] + w2 * x[e + 2] + w3 * x[e + 3]; if (t0 + tq * 8 + e < PADL) xr = 0.f;
                xs[(tq * 8 + e) * 64 + j] = xr; Xb[(tq * 8 + e) * GS + j] = f2bf(xr); }
        }
        if (t0 + 64 < TT) LRU_LOAD(t0 + 64);
        __syncthreads();
#pragma unroll
        for (int q = 0; q < 2; ++q) { const int tile = wid * 2 + q, ti = tile >> 2, tj = tile & 3;
            const f32x4 ca = mma_nt<false>(Xb, WaT, ti, tj, lane, (f32x4){0.f, 0.f, 0.f, 0.f});
            const f32x4 cx = mma_nt<false>(Xb, WxT, ti, tj, lane, (f32x4){0.f, 0.f, 0.f, 0.f});
#pragma unroll
            for (int e = 0; e < 4; ++e) { const int idx = (ti * 16 + 4 * fq + e) * 64 + tj * 16 + fr;
                const float r = sigmoidf_(ca[e] + gba[q]), ig = sigmoidf_(cx[e] + gbx[q]);
                const float la = gc[q] * r, x2 = 2.0f * la;
                const float om = (x2 > -0.25f) ? -x2 * (1.0f + x2 * (0.5f + x2 * (0.16666667f + x2 * (0.041666668f + x2 * (0.0083333338f + x2 * 0.0013888889f))))) : 1.0f - __expf(x2);
                as[idx] = __expf(la); bs[idx] = __builtin_sqrtf(om) * ig * xs[idx]; }
        }
        __syncthreads();
        if (wid == 0) {
#pragma unroll 8
            for (int t = 0; t < 64; ++t) { hst = as[t * 64 + lane] * hst + bs[t * 64 + lane]; YS[(size_t)(t0 + t) * 1024 + lane] = f2bf(hst); }
        }
    }
#undef LRU_LOAD
    __syncthreads();
}

__device__ __forceinline__ void gdn_gates_v(float araw, float braw, float A, float dtb, int lane, LAS float* betas, LAS float* Gs) {
    const float z = araw + dtb; const float spz = fmaxf(z, 0.f) + log1pf(expf(-fabsf(z)));
    float g = -A * spz;
#pragma unroll
    for (int o = 1; o < 64; o <<= 1) { const float u = __shfl_up(g, o); if (lane >= o) g += u; }
    betas[lane] = 1.0f / (1.0f + expf(-braw)); Gs[lane] = g;
}

__device__ __forceinline__ void gdn_pre_pair(const KP& p, int l, LAS unsigned char* lds, int pair) {
    const int tid = otid(), hf = tid >> 8, lt = tid & 255, wl = lt >> 6, lane = tid & 63, fr = lane & 15, fq = lane >> 4;
    const int cid = pair * 2 + hf, n = cid % 66, bh = cid / 66, b = bh >> 2, h = bh & 3, t0 = n * 64;
    const bool act = n != 0;
    bf16_t* GW = (bf16_t*)(p.out + OO_GW) + (size_t)cid * 4096; bf16_t* GU = (bf16_t*)(p.out + OO_GU) + (size_t)cid * 4096;
    LAS float* Kf = (LAS float*)(lds + hf * 61440);
    LAS float* Vf = Kf + 4096;
    LAS float* Mm = Vf + 4096;
    LAS float* betas = Mm + 4096; LAS float* Gs = betas + 64;
    LAS bf16_t* Kc = (LAS bf16_t*)(Gs + 64);
    const bf16_t* Pb = (const bf16_t*)(p.ws + OFF_BIG) + (size_t)b * TT * PN;
    const float* cw = p.inp(12) + (size_t)l * 4 * 768;
    __syncthreads();
    if (act) {
        const int ch = lt & 63, tq = lt >> 6, tb = t0 + tq * 16;
#pragma unroll
        for (int kv = 0; kv < 2; ++kv) {
            const bf16_t* P = Pb + (kv ? PC_GV : PC_GK) + h * 64 + ch; const float* w = cw + (kv ? 512 : 256) + h * 64 + ch; LAS float* dst = kv ? Vf : Kf;
            const float w0 = w[0], w1 = w[768], w2 = w[1536], w3 = w[2304];
            float x[19];
#pragma unroll
            for (int e = 0; e < 19; ++e) x[e] = bf2f(P[(size_t)(tb - 3 + e) * PN]);
#pragma unroll
            for (int e = 0; e < 16; ++e) dst[(tq * 16 + e) * 64 + ch] = siluf_(w0 * x[e] + w1 * x[e + 1] + w2 * x[e + 2] + w3 * x[e + 3]);
        }
        if (wl == 0) { const bf16_t* pr = Pb + (size_t)(t0 + lane) * PN;
            gdn_gates_v(bf2f(pr[PC_GA + h]), bf2f(pr[PC_GB + h]), expf(p.inp(13)[l * 4 + h]), p.inp(14)[l * 4 + h], lane, betas, Gs); }
    }
    __syncthreads();
    if (act) {
        const int row = lt >> 2, seg = lt & 3; float v[16]; float ss = 0.f;
#pragma unroll
        for (int e = 0; e < 16; ++e) { v[e] = Kf[row * 64 + seg * 16 + e]; ss += v[e] * v[e]; }
        ss += __shfl_xor(ss, 1); ss += __shfl_xor(ss, 2);
        const float rs = rsqrtf(ss + EPS);
#pragma unroll
        for (int e = 0; e < 16; ++e) { v[e] *= rs; Kf[row * 64 + seg * 16 + e] = v[e]; }
#pragma unroll
        for (int q = 0; q < 2; ++q) { u32x4 w; w.x = cvt_pk_bf16(v[8 * q], v[8 * q + 1]); w.y = cvt_pk_bf16(v[8 * q + 2], v[8 * q + 3]); w.z = cvt_pk_bf16(v[8 * q + 4], v[8 * q + 5]); w.w = cvt_pk_bf16(v[8 * q + 6], v[8 * q + 7]);
            *(LAS u32x4*)(Kc + row * GS + seg * 16 + q * 8) = w; }
    }
    __syncthreads();
    if (act) {
#pragma unroll
        for (int q = 0; q < 4; ++q) { const int tile = wl * 4 + q, ti = tile >> 2, tj = tile & 3;
            const f32x4 d = mma_nt<false>(Kc, Kc, ti, tj, lane, (f32x4){0.f, 0.f, 0.f, 0.f});
            const int i = tj * 16 + fr, j0 = ti * 16 + 4 * fq; const float bi = betas[i], gi = Gs[i];
            f32x4 o;
#pragma unroll
            for (int e = 0; e < 4; ++e) { const int jj = j0 + e; o[e] = (i > jj) ? bi * d[e] * __expf(gi - Gs[jj]) : 0.f; }
            *(LAS f32x4*)(Mm + i * 64 + j0) = o; }
    }
    __syncthreads();
    if (act && lt < 128) {
        const int col = lt & 63; const bool isw = lt < 64;
        float s[64];
#pragma unroll
        for (int i = 0; i < 64; ++i) {
            const float bi = betas[i];
            float r = isw ? Kf[i * 64 + col] * bi * __expf(Gs[i]) : Vf[i * 64 + col] * bi;
#pragma unroll
            for (int j4 = 0; j4 < (i + 3) / 4; ++j4) { const f32x4 mv = *(const LAS f32x4*)(Mm + i * 64 + j4 * 4);
#pragma unroll
                for (int e = 0; e < 4; ++e) if (j4 * 4 + e < i) r -= mv[e] * s[j4 * 4 + e]; }
            s[i] = r;
            if (isw) GW[i * 64 + col] = f2bf(r);
        }
        if (!isw) {
#pragma unroll
            for (int q = 0; q < 8; ++q) { u32x4 w; w.x = cvt_pk_bf16(s[q * 8], s[q * 8 + 1]); w.y = cvt_pk_bf16(s[q * 8 + 2], s[q * 8 + 3]); w.z = cvt_pk_bf16(s[q * 8 + 4], s[q * 8 + 5]); w.w = cvt_pk_bf16(s[q * 8 + 6], s[q * 8 + 7]);
                *(u32x4*)(GU + col * 64 + q * 8) = w; }
        }
    }
}

__device__ __forceinline__ void gdn_scan_item(const KP& p, int l, LAS unsigned char* lds, int bh) {
    const int tid = otid(), wid = tid >> 6, lane = tid & 63, fr = lane & 15, fq = lane >> 4;
    const int b = bh >> 2, h = bh & 3;
    LAS float* Qf = (LAS float*)lds;
    LAS float* Kf = Qf + 4096;
    LAS float* betas = Kf + 4096; LAS float* Gs = betas + 64;
    LAS bf16_t* Qc = (LAS bf16_t*)(Gs + 64);
    LAS bf16_t* Kc = Qc + 64 * GS; LAS bf16_t* QD = Kc + 64 * GS; LAS bf16_t* KDT = QD + 64 * GS; LAS bf16_t* QK = KDT + 64 * GS;
    LAS bf16_t* Wc = QK + 64 * GS; LAS bf16_t* ST = Wc + 64 * GS; LAS bf16_t* VNT = ST + 64 * GS; LAS bf16_t* UT = VNT + 64 * GS;
    const bf16_t* Pb = (const bf16_t*)(p.ws + OFF_BIG) + (size_t)b * TT * PN;
    const float* cw = p.inp(12) + (size_t)l * 4 * 768;
    bf16_t* YS = (bf16_t*)(p.out + OO_YS) + (size_t)b * TT * 1024 + 512 + h * 64;
    const float* gon = p.inp(15) + l * 64;
    const int ch = tid & 63, tq = tid >> 6, row = tid >> 3, seg = tid & 7;
    const float wq0 = cw[h * 64 + ch], wq1 = cw[768 + h * 64 + ch], wq2 = cw[1536 + h * 64 + ch], wq3 = cw[2304 + h * 64 + ch];
    const float wk0 = cw[256 + h * 64 + ch], wk1 = cw[768 + 256 + h * 64 + ch], wk2 = cw[1536 + 256 + h * 64 + ch], wk3 = cw[2304 + 256 + h * 64 + ch];
    const float Adec = expf(p.inp(13)[l * 4 + h]), dtb = p.inp(14)[l * 4 + h];
    const bf16_t* Pq = Pb + PC_GQ + h * 64 + ch; const bf16_t* Pk = Pb + PC_GK + h * 64 + ch;
    const bf16_t* GWb = (const bf16_t*)(p.out + OO_GW) + (size_t)bh * 66 * 4096 + row * 64 + seg * 8;
    const bf16_t* GUb = (const bf16_t*)(p.out + OO_GU) + (size_t)bh * 66 * 4096 + row * 64 + seg * 8;
    __syncthreads();
    for (int e = tid; e < 64 * GS / 2; e += NTHR) ((LAS unsigned*)ST)[e] = 0u;
    for (int e = tid; e < 64 * 16; e += NTHR) *(u32x2*)(YS + (size_t)(e >> 4) * 1024 + (e & 15) * 4) = (u32x2){0u, 0u};
    f32x4 Sacc[2] = {(f32x4){0.f, 0.f, 0.f, 0.f}, (f32x4){0.f, 0.f, 0.f, 0.f}};
    bf16_t xq[11], xk[11]; u32x4 wreg, ureg; bf16_t araw = 0, braw = 0; u32x2 ggn[4], ggc[4];
#pragma unroll
    for (int tv = 0; tv < 4; ++tv) { ggn[tv] = (u32x2){0u, 0u}; ggc[tv] = (u32x2){0u, 0u}; }
#define GDN_LOAD(n_) do { const int t0_ = (n_) * 64, tb_ = t0_ + tq * 8; \
        _Pragma("unroll") for (int e = 0; e < 11; ++e) { xq[e] = Pq[(size_t)(tb_ - 3 + e) * PN]; xk[e] = Pk[(size_t)(tb_ - 3 + e) * PN]; } \
        wreg = *(const u32x4*)(GWb + (size_t)(n_) * 4096); ureg = *(const u32x4*)(GUb + (size_t)(n_) * 4096); \
        if (wid == 0) { const bf16_t* pr_ = Pb + (size_t)(t0_ + lane) * PN; araw = pr_[PC_GA + h]; braw = pr_[PC_GB + h]; } \
        if (wid < 4) { const bf16_t* gp_ = Pb + (size_t)(t0_ + wid * 16 + fr) * PN + PC_GG + h * 64 + 4 * fq; \
            _Pragma("unroll") for (int tv = 0; tv < 4; ++tv) ggn[tv] = *(const u32x2*)(gp_ + tv * 16); } } while (0)
    GDN_LOAD(1);
    for (int n = 1; n < 66; ++n) {
        const int t0 = n * 64;
        {
            float x[11];
#pragma unroll
            for (int e = 0; e < 11; ++e) x[e] = bf2f(xq[e]);
#pragma unroll
            for (int e = 0; e < 8; ++e) Qf[(tq * 8 + e) * 64 + ch] = siluf_(wq0 * x[e] + wq1 * x[e + 1] + wq2 * x[e + 2] + wq3 * x[e + 3]);
#pragma unroll
            for (int e = 0; e < 11; ++e) x[e] = bf2f(xk[e]);
#pragma unroll
            for (int e = 0; e < 8; ++e) Kf[(tq * 8 + e) * 64 + ch] = siluf_(wk0 * x[e] + wk1 * x[e + 1] + wk2 * x[e + 2] + wk3 * x[e + 3]);
            if (wid == 0) gdn_gates_v(bf2f(araw), bf2f(braw), Adec, dtb, lane, betas, Gs);
            *(LAS u32x4*)(Wc + row * GS + seg * 8) = wreg; *(LAS u32x4*)(UT + row * GS + seg * 8) = ureg;
#pragma unroll
            for (int tv = 0; tv < 4; ++tv) ggc[tv] = ggn[tv];
        }
        if (n + 1 < 66) GDN_LOAD(n + 1);
        __syncthreads();
        {
            float q[8], k[8]; float sq = 0.f, sk = 0.f;
#pragma unroll
            for (int e = 0; e < 8; ++e) { q[e] = Qf[row * 64 + seg * 8 + e]; k[e] = Kf[row * 64 + seg * 8 + e]; sq += q[e] * q[e]; sk += k[e] * k[e]; }
            sq += __shfl_xor(sq, 1); sq += __shfl_xor(sq, 2); sq += __shfl_xor(sq, 4);
            sk += __shfl_xor(sk, 1); sk += __shfl_xor(sk, 2); sk += __shfl_xor(sk, 4);
            const float rq = rsqrtf(sq + EPS) * 0.125f, rk = rsqrtf(sk + EPS);
            const float g = Gs[row], eg = __expf(g), ekd = __expf(Gs[63] - g);
#pragma unroll
            for (int e = 0; e < 8; ++e) { q[e] *= rq; k[e] *= rk; }
            u32x4 w; w.x = cvt_pk_bf16(q[0], q[1]); w.y = cvt_pk_bf16(q[2], q[3]); w.z = cvt_pk_bf16(q[4], q[5]); w.w = cvt_pk_bf16(q[6], q[7]);
            *(LAS u32x4*)(Qc + row * GS + seg * 8) = w;
            w.x = cvt_pk_bf16(q[0] * eg, q[1] * eg); w.y = cvt_pk_bf16(q[2] * eg, q[3] * eg); w.z = cvt_pk_bf16(q[4] * eg, q[5] * eg); w.w = cvt_pk_bf16(q[6] * eg, q[7] * eg);
            *(LAS u32x4*)(QD + row * GS + seg * 8) = w;
            w.x = cvt_pk_bf16(k[0], k[1]); w.y = cvt_pk_bf16(k[2], k[3]); w.z = cvt_pk_bf16(k[4], k[5]); w.w = cvt_pk_bf16(k[6], k[7]);
            *(LAS u32x4*)(Kc + row * GS + seg * 8) = w;
#pragma unroll
            for (int e = 0; e < 8; ++e) KDT[(seg * 8 + e) * GS + row] = f2bf(k[e] * ekd);
        }
        __syncthreads();
        {
#pragma unroll
            for (int q = 0; q < 2; ++q) { const int tile = wid * 2 + q, ti = tile >> 2, tj = tile & 3;
                const f32x4 d = mma_nt<true>(Qc, Kc, ti, tj, lane, (f32x4){0.f, 0.f, 0.f, 0.f});
                const int i = ti * 16 + fr, j0 = tj * 16 + 4 * fq; const float gi = Gs[i];
                float o[4];
#pragma unroll
                for (int e = 0; e < 4; ++e) { const int jj = j0 + e; o[e] = (i >= jj) ? d[e] * __expf(gi - Gs[jj]) : 0.f; }
                u32x2 w; w.x = cvt_pk_bf16(o[0], o[1]); w.y = cvt_pk_bf16(o[2], o[3]);
                *(LAS u32x2*)(QK + i * GS + j0) = w; }
#pragma unroll
            for (int q = 0; q < 2; ++q) { const int tile = wid * 2 + q, ti = tile >> 2, tj = tile & 3;
                const f32x4 d = mma_nt<false>(Wc, ST, ti, tj, lane, (f32x4){0.f, 0.f, 0.f, 0.f});
                const int dv = tj * 16 + fr, c0 = ti * 16 + 4 * fq;
                const u32x2 uu = *(const LAS u32x2*)(UT + dv * GS + c0);
                u32x2 w; w.x = cvt_pk_bf16(bflo(uu.x) - d[0], bfhi(uu.x) - d[1]); w.y = cvt_pk_bf16(bflo(uu.y) - d[2], bfhi(uu.y) - d[3]);
                *(LAS u32x2*)(VNT + dv * GS + c0) = w; }
        }
        __syncthreads();
        {
            const float gl = __expf(Gs[63]);
            if (wid < 4) {
                f32x4 o[4];
#pragma unroll
                for (int tv = 0; tv < 4; ++tv) { o[tv] = mma_nt<true>(QD, ST, wid, tv, lane, (f32x4){0.f, 0.f, 0.f, 0.f}); o[tv] = mma_nt<true>(QK, VNT, wid, tv, lane, o[tv]); }
                float ss = 0.f;
#pragma unroll
                for (int tv = 0; tv < 4; ++tv) ss += o[tv][0] * o[tv][0] + o[tv][1] * o[tv][1] + o[tv][2] * o[tv][2] + o[tv][3] * o[tv][3];
                ss += __shfl_xor(ss, 16); ss += __shfl_xor(ss, 32);
                const float rs = rsqrtf(ss * (1.0f / 64.0f) + EPS);
                const int t = t0 + wid * 16 + fr;
#pragma unroll
                for (int tv = 0; tv < 4; ++tv) { const int dv = tv * 16 + 4 * fq;
                    const u32x2 gg = ggc[tv]; const f32x4 gn = *(const f32x4*)(gon + dv);
                    u32x2 w; w.x = cvt_pk_bf16(o[tv][0] * rs * gn[0] * siluf_(bflo(gg.x)), o[tv][1] * rs * gn[1] * siluf_(bfhi(gg.x)));
                    w.y = cvt_pk_bf16(o[tv][2] * rs * gn[2] * siluf_(bflo(gg.y)), o[tv][3] * rs * gn[3] * siluf_(bfhi(gg.y)));
                    if (t < PADL) { w.x = 0u; w.y = 0u; }
                    *(u32x2*)(YS + (size_t)t * 1024 + dv) = w; }
            }
#pragma unroll
            for (int q = 0; q < 2; ++q) { const int tile = wid * 2 + q, ti = tile >> 2, tj = tile & 3;
                Sacc[q] = mma_nt<false>(KDT, VNT, ti, tj, lane, Sacc[q] * gl); }
        }
        __syncthreads();
#pragma unroll
        for (int q = 0; q < 2; ++q) { const int tile = wid * 2 + q, ti = tile >> 2, tj = tile & 3;
            u32x2 w; w.x = cvt_pk_bf16(Sacc[q][0], Sacc[q][1]); w.y = cvt_pk_bf16(Sacc[q][2], Sacc[q][3]);
            *(LAS u32x2*)(ST + (tj * 16 + fr) * GS + ti * 16 + 4 * fq) = w; }
    }
#undef GDN_LOAD
    __syncthreads();
}

__device__ __forceinline__ int vt_pos(int t) { return (t & ~15) + 8 * ((t >> 2) & 1) + 4 * ((t >> 3) & 1) + (t & 3); }
template <int DK, bool FOX>
__device__ __forceinline__ void attn_item(LAS unsigned char* lds, const bf16_t* Qp, int ldq, const bf16_t* Kp, int ldk, const bf16_t* Vp  ,
                          const float* cum2, const float* rope, float c1, bf16_t* Op, int qt) {
    constexpr int KST = DK + 8, NDS = DK / 16, KPIECES = 64 * DK / 8, BUFB = 64 * KST * 2 + 64 * 72 * 2 + 256;
    const int tid = otid(), wid = tid >> 6, lane = tid & 63, qi = lane & 31, half = lane >> 5;
    const int q0 = qt * 256 + wid * 32, tq = q0 + qi;
    const bool wact = q0 < TT;
    bf16x8 qf[NDS];
#pragma unroll
    for (int ds = 0; ds < NDS; ++ds) qf[ds] = (tq < TT) ? *(const bf16x8*)(Qp + (size_t)tq * ldq + ds * 16 + 8 * half) : (bf16x8){0, 0, 0, 0, 0, 0, 0, 0};
    if (!FOX) {
        const int tr = tq < TT ? tq : TT - 1;
        const float* cs = rope + tr * 16 + 8 * half; const float* sn = rope + TT * 16 + tr * 16 + 8 * half;
        u32x4 a = *(u32x4*)&qf[NDS - 2], b = *(u32x4*)&qf[NDS - 1];
        unsigned aw[4] = {a.x, a.y, a.z, a.w}, bw[4] = {b.x, b.y, b.z, b.w};
#pragma unroll
        for (int e = 0; e < 4; ++e) { const float c0 = cs[2 * e], c1_ = cs[2 * e + 1], s0_ = sn[2 * e], s1_ = sn[2 * e + 1];
            const float x1l = bflo(aw[e]), x1h = bfhi(aw[e]), x2l = bflo(bw[e]), x2h = bfhi(bw[e]);
            aw[e] = cvt_pk_bf16(x1l * c0 - x2l * s0_, x1h * c1_ - x2h * s1_); bw[e] = cvt_pk_bf16(x2l * c0 + x1l * s0_, x2h * c1_ + x1h * s1_); }
        a = (u32x4){aw[0], aw[1], aw[2], aw[3]}; b = (u32x4){bw[0], bw[1], bw[2], bw[3]};
        qf[NDS - 2] = *(bf16x8*)&a; qf[NDS - 1] = *(bf16x8*)&b;
    }
    const float cq = FOX ? cum2[tq < TT ? tq : TT - 1] : 0.f;
    f32x16 o0, o1;
#pragma unroll
    for (int r = 0; r < 16; ++r) { o0[r] = 0.f; o1[r] = 0.f; }
    float mrow = -1e30f, lrow = 0.f;
    const int jmax = (4 * qt + 3) < 65 ? (4 * qt + 3) : 65;
    const int jw = (q0 + 31) >> 6;
    u32x4 kr0, kr1, vr; float cr = 0.f;
    const int kkey0 = tid / (DK / 8), kseg0 = tid % (DK / 8), kkey1 = (tid + 512) / (DK / 8), kseg1 = (tid + 512) % (DK / 8);
    const int vd = tid >> 3, vseg = tid & 7;
#define ATT_PREFETCH(j) do { const size_t kb_ = (size_t)(j) * 64; \
        kr0 = *(const u32x4*)(Kp + (kb_ + kkey0) * ldk + kseg0 * 8); \
        if (KPIECES > 512 && tid + 512 < KPIECES) kr1 = *(const u32x4*)(Kp + (kb_ + kkey1) * ldk + kseg1 * 8); \
        vr = *(const u32x4*)(Vp + (size_t)vd * TT + kb_ + vseg * 8); \
        if (FOX && tid < 64) cr = cum2[kb_ + tid]; } while (0)
#define ATT_WRITE(buf) do { LAS bf16_t* Ks_ = (LAS bf16_t*)(lds + (buf) * BUFB); LAS bf16_t* Vt_ = Ks_ + 64 * KST; \
        *(LAS u32x4*)(Ks_ + kkey0 * KST + kseg0 * 8) = kr0; \
        if (KPIECES > 512 && tid + 512 < KPIECES) *(LAS u32x4*)(Ks_ + kkey1 * KST + kseg1 * 8) = kr1; \
        *(LAS u32x4*)(Vt_ + vd * 72 + vseg * 8) = vr; \
        if (FOX && tid < 64) ((LAS float*)(Vt_ + 64 * 72))[tid] = cr; } while (0)
    kr1 = (u32x4){0u, 0u, 0u, 0u};
    __syncthreads();
    ATT_PREFETCH(1);
    ATT_WRITE(1);
    if (2 <= jmax) ATT_PREFETCH(2);
    __syncthreads();
    for (int j = 1; j <= jmax; ++j) {
        if (j + 1 <= jmax) ATT_WRITE((j + 1) & 1);
        if (j + 2 <= jmax) ATT_PREFETCH(j + 2);
        if (wact && j <= jw) {
            const LAS bf16_t* Ks = (const LAS bf16_t*)(lds + (j & 1) * BUFB); const LAS bf16_t* Vt = Ks + 64 * KST; const LAS float* Cs = (const LAS float*)(Vt + 64 * 72);
            f32x16 s0, s1;
#pragma unroll
            for (int r = 0; r < 16; ++r) { s0[r] = 0.f; s1[r] = 0.f; }
#pragma unroll
            for (int ds = 0; ds < NDS; ++ds) {
                const bf16x8 a0 = *(const LAS bf16x8*)(Ks + qi * KST + ds * 16 + 8 * half);
                const bf16x8 a1 = *(const LAS bf16x8*)(Ks + (32 + qi) * KST + ds * 16 + 8 * half);
                s0 = __builtin_amdgcn_mfma_f32_32x32x16_bf16(a0, qf[ds], s0, 0, 0, 0);
                s1 = __builtin_amdgcn_mfma_f32_32x32x16_bf16(a1, qf[ds], s1, 0, 0, 0);
            }
            const bool need_mask = (j == 1) || (j * 64 + 63 > q0);
            float mx = -1e30f;
#pragma unroll
            for (int g = 0; g < 4; ++g) {
                f32x4 c0v = (f32x4){0.f, 0.f, 0.f, 0.f}, c1v = c0v;
                if (FOX) { c0v = *(const LAS f32x4*)(Cs + g * 8 + half * 4); c1v = *(const LAS f32x4*)(Cs + 32 + g * 8 + half * 4); }
#pragma unroll
                for (int e = 0; e < 4; ++e) { const int r = g * 4 + e; const int kl = g * 8 + half * 4 + e;
                    float x0 = s0[r] * c1, x1 = s1[r] * c1;
                    if (FOX) { x0 += cq - c0v[e]; x1 += cq - c1v[e]; }
                    if (need_mask) { const int key0 = j * 64 + kl, key1 = key0 + 32;
                        if (key0 < PADL || key0 > tq) x0 = -1e30f;
                        if (key1 < PADL || key1 > tq) x1 = -1e30f; }
                    s0[r] = x0; s1[r] = x1; mx = fmaxf(mx, fmaxf(x0, x1)); }
            }
            mx = fmaxf(mx, __shfl_xor(mx, 32));
            const float mnew = fmaxf(mrow, mx), alpha = __builtin_amdgcn_exp2f(mrow - mnew);
            float rs = 0.f;
#pragma unroll
            for (int r = 0; r < 16; ++r) { s0[r] = __builtin_amdgcn_exp2f(s0[r] - mnew); s1[r] = __builtin_amdgcn_exp2f(s1[r] - mnew); rs += s0[r] + s1[r]; }
            rs += __shfl_xor(rs, 32);
            lrow = lrow * alpha + rs; mrow = mnew;
#pragma unroll
            for (int r = 0; r < 16; ++r) { o0[r] *= alpha; o1[r] *= alpha; }
#pragma unroll
            for (int s = 0; s < 4; ++s) {
                bf16x8 pf;
                {
                    unsigned w[4];
#pragma unroll
                    for (int e = 0; e < 4; ++e) { const int r = 8 * (s & 1) + 2 * e; w[e] = (s < 2) ? cvt_pk_bf16(s0[r], s0[r + 1]) : cvt_pk_bf16(s1[r], s1[r + 1]); }
                    u32x4 ww = (u32x4){w[0], w[1], w[2], w[3]}; pf = *(bf16x8*)&ww;
                }
                const bf16x8 v0 = *(const LAS bf16x8*)(Vt + qi * 72 + 16 * s + 8 * half);
                const bf16x8 v1 = *(const LAS bf16x8*)(Vt + (32 + qi) * 72 + 16 * s + 8 * half);
                o0 = __builtin_amdgcn_mfma_f32_32x32x16_bf16(v0, pf, o0, 0, 0, 0);
                o1 = __builtin_amdgcn_mfma_f32_32x32x16_bf16(v1, pf, o1, 0, 0, 0);
            }
        }
        __syncthreads();
    }
#undef ATT_PREFETCH
#undef ATT_WRITE
    if (tq < TT) {
        const float inv = (tq >= PADL && lrow > 0.f) ? 1.0f / lrow : 0.f;
        bf16_t* orow = Op + (size_t)tq * 1024;
#pragma unroll
        for (int g = 0; g < 4; ++g) {
            u32x2 w; w.x = cvt_pk_bf16(o0[4 * g] * inv, o0[4 * g + 1] * inv); w.y = cvt_pk_bf16(o0[4 * g + 2] * inv, o0[4 * g + 3] * inv);
            *(u32x2*)(orow + 8 * g + 4 * half) = w;
            w.x = cvt_pk_bf16(o1[4 * g] * inv, o1[4 * g + 1] * inv); w.y = cvt_pk_bf16(o1[4 * g + 2] * inv, o1[4 * g + 3] * inv);
            *(u32x2*)(orow + 32 + 8 * g + 4 * half) = w;
        }
    }
}
__device__ __forceinline__ void phase_attn(const KP& p, LAS unsigned char* lds, int vb, int nvb, int kinds) {
    const bf16_t* P = (const bf16_t*)(p.ws + OFF_BIG);
    const bf16_t* Qm = (const bf16_t*)(p.ws + OFF_QM); const bf16_t* Km = (const bf16_t*)(p.ws + OFF_KM);
    const bf16_t* VTM = (const bf16_t*)(p.out + OO_VM); const bf16_t* VTF = (const bf16_t*)(p.ws + OFF_VTF);
    const float* cum = (const float*)(p.ws + OFF_CUM);
    bf16_t* YS = (bf16_t*)(p.out + OO_YS);
    const int per = (kinds == 3) ? 128 : 64, nitems = 17 * per;
    for (int rnd = 0;; ++rnd) {
        const int idx = rnd * nvb + ((rnd & 1) ? (nvb - 1 - vb) : vb);
        if (rnd * nvb >= nitems) break;
        if (idx >= nitems) continue;
        const int qt = 16 - idx / per; const int rem = idx % per;
        int kind, bh;
        if (kinds == 3) { kind = rem & 1; bh = rem >> 1; } else { kind = (kinds == 2); bh = rem; }
        const int b = bh >> 2, h = bh & 3;
        if (kind == 0)
            attn_item<64, true>(lds, P + (size_t)b * TT * PN + PC_FQ + h * 64, PN, P + (size_t)b * TT * PN + PC_FK + h * 64, PN, VTF + (size_t)bh * 64 * TT,
                                cum + (size_t)bh * TT, nullptr, 0.125f * LOG2E, YS + (size_t)b * TT * 1024 + h * 64, qt);
        else
            attn_item<96, false>(lds, Qm + (size_t)b * TT * 384 + h * 96, 384, Km + (size_t)b * TT * 384 + h * 96, 384, VTM + (size_t)bh * 64 * TT,
                                 nullptr, (const float*)(p.ws + OFF_ROPE), 0.10206207261596577f * LOG2E, YS + (size_t)b * TT * 1024 + 256 + h * 64, qt);
    }
    __syncthreads();
}

constexpr int NPL = 13, NPH = 2 + 2 * NPL;

template <int ph>
__device__ __forceinline__ void run_phase(const KP& p, LAS unsigned char* lds) {
    const int G = ogdim(), c = obid();
    char* ws = p.ws;
    int kind = -1, l = 0;
    int s = -1;
    if (ph == 0) { if (EN_MASK & 1) phase_prep(p, lds); phase_rmsnorm(p, nullptr, 2); return; }
    if (ph == NPH - 1) { phase_rmsnorm(p, p.inp(30), 3); return; }
    l = (ph - 1) / NPL; s = (ph - 1) % NPL;
    const char* W = ws + OFF_W + (size_t)l * W_LAYER;
    pg8::ssq_t* SSb = (pg8::ssq_t*)(ws + OFF_SS);
    const pg8::ssq_t* SS = SSb + (size_t)NT * ((s == 0) ? 3 * l : (s == 11) ? 3 * l + 2 : 3 * l + 1);
    pg8::ssq_t* SSw = SSb + (size_t)NT * ((s == 1) ? 3 * l + 1 : (s == 10) ? 3 * l + 2 : (3 * l + 3) % 6);
    pg8::Sched S;
    const void* gA = nullptr; const void* gB = nullptr; int gK = 0, lda = 0, ldb = 0, half = 0; float alpha = 0.f;
    switch (s) {
    case 0: kind = 0; gA = ws + OFF_UN; gB = W + W_WI1; break;
    case 11: kind = 0; gA = ws + OFF_UN; gB = W + W_WI2; break;
    case 1: kind = 1; gA = ws + OFF_BIG; gB = W + W_WO1; gK = FF; lda = FF; ldb = FF; alpha = 0.5f; break;
    case 12: kind = 1; gA = ws + OFF_BIG; gB = W + W_WO2; gK = FF; lda = FF; ldb = FF; alpha = 0.5f; break;
    case 10: kind = 1; gA = ws + OFF_MERGED; gB = W + W_WOUT; gK = DM; lda = DM; ldb = DM; alpha = 1.0f; break;
    case 2: kind = 2; break;
    case 3: {
        phase_mla_pre(p, l);
        if (c >= 128 && c < 192) fox_cum_item(p, l, lds, c - 128);
        if (c < 64) { if (EN_MASK & 2) lru_item(p, l, lds, c); }
        else if (EN_MASK & 4) { for (int pr = c - 64; pr < NB * 4 * 33; pr += G - 64) gdn_pre_pair(p, l, lds, pr); }
        return; }
    case 4: kind = 3; break;
    case 5: if (EN_MASK & 8) phase_attn(p, lds, c, G, 2); return;
    case 6: kind = 4; half = 0; break;
    case 8: kind = 4; half = 1; break;
    case 7: kind = 5; half = 0; break;
    case 9: kind = 5; half = 1; break;
    default: return;
    }
    if (!(EN_MASK & 32)) return;
    if (!((GK_MASK >> kind) & 1)) return;
    switch (kind) {
    case 0: if ((GK_MASK >> 0) & 1) { S.init(NT / 256, 2 * FF / 256, G, c, 0, gA, DM, gB, DM); pg8::EpiSwiglu E{(bf16_t*)(ws + OFF_BIG), SS}; pg8::gemm_phase(lds, DM, DM, DM, S, E); break; }
    case 1: if ((GK_MASK >> 1) & 1) { S.init(NT / 256, DM / 256, G, c, 0, gA, lda, gB, ldb); pg8::EpiResid E{(float*)(ws + OFF_H), alpha, (bf16_t*)(ws + OFF_UN), SSw}; pg8::gemm_phase(lds, gK, lda, ldb, S, E); break; }
    case 2: if ((GK_MASK >> 2) & 1) { S.init(NT / 256, PN / 256, G, c, 0, ws + OFF_UN, DM, W + W_WIN, DM); pg8::EpiBf16 E{(bf16_t*)(ws + OFF_BIG), PN, 0, (bf16_t*)(ws + OFF_VTF), SS}; pg8::gemm_phase(lds, DM, DM, DM, S, E); break; }
    case 3: if ((GK_MASK >> 3) & 1) {
              if (c < 64) { if (EN_MASK & 16) gdn_scan_item(p, l, lds, c); }
              else { S.init(NT / 256, 4, G - 64, c - 64, 0, ws + OFF_AMLA, 384, W + W_WUP, 384);
                  pg8::EpiMlaUp E{(bf16_t*)(ws + OFF_QM), (bf16_t*)(ws + OFF_KM), (bf16_t*)(p.out + OO_VM)}; pg8::gemm_phase(lds, 384, 384, 384, S, E);
                  __syncthreads();
                  if (EN_MASK & 8) phase_attn(p, lds, c - 64, G - 64, 1); }
              break; }
    case 4: if ((GK_MASK >> 4) & 1) { S.init(HR / 256, 16, G, c, 1, p.out + OO_YS + (size_t)half * HR * 1024 * 2, 1024, W + W_WB, 256);
              pg8::EpiBf16 E{(bf16_t*)(ws + OFF_BIG), 1024, 1, nullptr, nullptr}; pg8::gemm_phase(lds, 256, 1024, 256, S, E); break; }
    case 5: if ((GK_MASK >> 5) & 1) { S.init(HR / 256, 16, G, c, 0, ws + OFF_UN + (size_t)half * HR * DM * 2, DM, W + W_WG, DM);
              pg8::EpiGate E{(bf16_t*)(ws + OFF_MERGED), (const bf16_t*)(ws + OFF_BIG), p.inp(24) + (size_t)l * 4 * DM, half * HR, SS}; pg8::gemm_phase(lds, DM, DM, DM, S, E); break; }
    default: break;
    }
}

template <int PH>
__device__ __forceinline__ void run_all(const KP& p, LAS unsigned char* lds) {
    if constexpr (PH < NPH) {
        run_phase<PH>(p, lds);
        if constexpr (PH >= 1 && PH < NPH - 1 && ((REP_MASK >> ((PH - 1) % NPL)) & 1)) { cg::this_grid().sync(); run_phase<PH>(p, lds); }
        if constexpr (PH + 1 < NPH) cg::this_grid().sync();
        run_all<PH + 1>(p, lds);
    }
}
__global__ void __launch_bounds__(NTHR, 2) mega_kernel(KPA pa) {
    extern __shared__ __attribute__((aligned(16))) unsigned char smem[];
    LAS unsigned char* lds = (LAS unsigned char*)smem;
    KP p;
#pragma unroll
    for (int i = 0; i < 31; ++i) p.in[i] = pa.in[i];
    p.ws = pa.ws; p.out = pa.out; p.lo = 0; p.hi = 0;
    run_all<0>(p, lds);
}

extern "C" void kernel_launch(void* const* d_in, const int* in_sizes, int n_in, void* d_out, int out_size, void* d_ws, size_t ws_size, hipStream_t stream) {
    static int grid = 0;
    if (grid == 0) {
        if (n_in != 31 || ws_size < WS_END) { fprintf(stderr, "kernel_launch: unexpected n_in %d / ws %zu (need %zu)\n", n_in, ws_size, (size_t)WS_END); grid = -1; return; }
        int dev = 0, cus = 0, per_cu = 0;
        hipGetDevice(&dev); hipDeviceGetAttribute(&cus, hipDeviceAttributeMultiprocessorCount, dev);
        if (hipFuncSetAttribute((const void*)mega_kernel, hipFuncAttributeMaxDynamicSharedMemorySize, LDS_BYTES) != hipSuccess) { fprintf(stderr, "kernel_launch: hipFuncSetAttribute failed\n"); grid = -1; return; }
        if (hipOccupancyMaxActiveBlocksPerMultiprocessor(&per_cu, (const void*)mega_kernel, NTHR, LDS_BYTES) != hipSuccess || per_cu < 1) { fprintf(stderr, "kernel_launch: occupancy query says %d\n", per_cu); per_cu = 1; }
        (void)hipGetLastError();
        grid = cus;
    }
    if (grid < 0) return;
    KPA a; memset(&a, 0, sizeof(a));
    for (int i = 0; i < 31; ++i) a.in[i] = (const float*)d_in[i];
    a.ws = (char*)d_ws; a.out = (char*)d_out;
    a.lo = 0; a.hi = NPH;
    void* args[] = {&a};
    hipError_t e = hipLaunchCooperativeKernel((const void*)mega_kernel, dim3(grid), dim3(NTHR), args, LDS_BYTES, stream);
    if (e != hipSuccess) fprintf(stderr, "cooperative launch failed: %s (grid %d)\n", hipGetErrorString(e), grid);
}
```

```cpp
#include <hip/hip_runtime.h>
#include <hip/hip_cooperative_groups.h>
#include <cstdio>
#include <cstring>
namespace cg = cooperative_groups;

#ifndef SUBREP
#define SUBREP 0
#endif
#ifndef REP_MASK
#define REP_MASK 0
#endif
#ifndef GK_MASK
#define GK_MASK 0xff
#endif
#ifndef EN_MASK
#define EN_MASK 0xff
#endif
#ifndef ONE_LAUNCH
#define ONE_LAUNCH 1
#endif

#define LAS __attribute__((address_space(3)))
typedef unsigned short bf16_t;
typedef short bf16x8 __attribute__((ext_vector_type(8)));
typedef float f32x4 __attribute__((ext_vector_type(4)));
typedef float f32x16 __attribute__((ext_vector_type(16)));
typedef unsigned u32x4 __attribute__((ext_vector_type(4)));
typedef unsigned u32x2 __attribute__((ext_vector_type(2)));

constexpr int NB = 16, TT = 4224, NT = NB * TT, DM = 1024, FF = 2816, PADL = 112, PN = 2560;
constexpr int HR0 = 128 * 256, HR = 136 * 256;
static_assert(HR0 + HR == NT, "halves");
constexpr float EPS = 1e-6f, LOG2E = 1.4426950408889634f;
constexpr int NTHR = 512, LDS_BYTES = 131072;
constexpr int PC_FQ = 0, PC_FK = 256, PC_FV = 512, PC_CQ = 768, PC_CKV = 960, PC_KR = 1088, PC_GQ = 1120, PC_GK = 1376, PC_GV = 1632,
              PC_GG = 1888, PC_LRU = 2144, PC_FF = 2400, PC_GA = 2404, PC_GB = 2408;
constexpr size_t W_WI1 = 0, W_WO1 = W_WI1 + 5632ull * 1024 * 2, W_WI2 = W_WO1 + 1024ull * 2816 * 2, W_WO2 = W_WI2 + 5632ull * 1024 * 2,
                 W_WIN = W_WO2 + 1024ull * 2816 * 2, W_WUP = W_WIN + 2560ull * 1024 * 2, W_WG = W_WUP + 1024ull * 384 * 2,
                 W_WB = W_WG + 4096ull * 1024 * 2, W_WOUT = W_WB + 4096ull * 256 * 2, W_LAYER = W_WOUT + 1024ull * 1024 * 2;
constexpr size_t OFF_H = 0, OFF_W = OFF_H + (size_t)NT * DM * 4, OFF_UN = OFF_W + 2 * W_LAYER, OFF_BIG = OFF_UN + (size_t)NT * DM * 2,
                 OFF_REST = OFF_BIG + (size_t)NT * FF * 2;
constexpr size_t OFF_AMLA = OFF_REST, OFF_QM = OFF_AMLA + (size_t)NT * 384 * 2, OFF_KM = OFF_QM + (size_t)NT * 384 * 2,
                 OFF_CUM = OFF_KM + (size_t)NT * 384 * 2, OFF_ROPE = OFF_CUM + (size_t)NB * 4 * TT * 4, OFF_SS = OFF_ROPE + (size_t)TT * 32 * 4, OFF_CTR = OFF_SS + (size_t)NT * 6 * 8, WS_END = OFF_CTR + 256;
constexpr size_t OFF_MERGED = OFF_REST;
constexpr size_t OFF_VTF = OFF_BIG + (size_t)NT * PN * 2;
static_assert(OFF_VTF + (size_t)NT * 256 * 2 <= OFF_REST, "vtf");
static_assert(WS_END <= (1ull << 30), "workspace");
constexpr size_t OO_YS = 0, OO_VM = OO_YS + (size_t)NT * 1024 * 2, OO_GW = OO_VM + (size_t)NT * 256 * 2,
                 OO_GU = OO_GW + (size_t)NB * 4 * 66 * 4096 * 2, OO_END = OO_GU + (size_t)NB * 4 * 66 * 4096 * 2;
static_assert(OO_END <= (size_t)NB * 4096 * 1024 * 4, "out scratch");

struct KP { const float* in[31]; char* ws; char* out; int lo, hi;
    __device__ __forceinline__ const float* inp(int i) const { return in[i]; } };
typedef KP KPA;

__device__ __forceinline__ unsigned cvt_pk_bf16(float lo, float hi) { unsigned r; asm("v_cvt_pk_bf16_f32 %0, %1, %2" : "=v"(r) : "v"(lo), "v"(hi)); return r; }
__device__ __forceinline__ bf16_t f2bf(float f) { return (bf16_t)(cvt_pk_bf16(f, 0.f) & 0xffffu); }
__device__ __forceinline__ float bf2f(bf16_t b) { return __uint_as_float(((unsigned)b) << 16); }
__device__ __forceinline__ float bflo(unsigned w) { return __uint_as_float(w << 16); }
__device__ __forceinline__ float bfhi(unsigned w) { return __uint_as_float(w & 0xffff0000u); }
__device__ __forceinline__ float sigmoidf_(float x) { return __builtin_amdgcn_rcpf(1.0f + __expf(-x)); }
__device__ __forceinline__ float siluf_(float x) { return x * sigmoidf_(x); }
__device__ __forceinline__ int otid() { int t = threadIdx.x; asm volatile("" : "+v"(t)); return t; }
__device__ __forceinline__ int obid() { return (int)blockIdx.x; }
__device__ __forceinline__ int ogdim() { return (int)gridDim.x; }
__device__ __forceinline__ float wave_sum(float v) {
#pragma unroll
    for (int o = 32; o >= 1; o >>= 1) v += __shfl_xor(v, o);
    return v;
}

namespace pg8 {
constexpr int BM = 256, BK = 64, HALF = 128, HTB = HALF * BK * 2, NXCD = 8, WGM = 8;
__device__ __forceinline__ int lds_byte(int r, int c) { const int st = (r >> 4) * 2 + (c >> 5), rr = r & 15, cc = c & 31, ob = rr * 64 + cc * 2; return st * 1024 + (ob ^ (((ob >> 9) & 1) << 5)); }
__device__ __forceinline__ void stage_rc(int b, int& R, int& C) { const int st = b / 1024, sb = b % 1024, swz = sb ^ (((sb >> 9) & 1) << 5); R = (st >> 1) * 16 + swz / 64; C = (st & 1) * 32 + (swz % 64) / 2; }
__device__ __forceinline__ int perm32(int rho) { const int n = rho >> 4, i = rho & 15; return 8 * (i >> 2) + 4 * n + (i & 3); }

__device__ __forceinline__ const char* uptr(const char* p) { const unsigned long long v = (unsigned long long)p;
    const unsigned lo = __builtin_amdgcn_readfirstlane((unsigned)v), hi = __builtin_amdgcn_readfirstlane((unsigned)(v >> 32)); return (const char*)(((unsigned long long)hi << 32) | lo); }
struct Unit { int pm, pn; const char* pa; const char* pb; };
struct Sched {
    int nM, nN, nwg, G, c, mode; const char* A; const char* B; size_t tA, tB;
    __device__ void init(int nM_, int nN_, int G_, int c_, int mode_, const void* A_, int lda, const void* B_, int ldb) {
        nM = nM_; nN = nN_; nwg = nM * nN; G = G_; c = c_; mode = mode_; A = (const char*)A_; B = (const char*)B_; tA = (size_t)BM * lda * 2; tB = (size_t)BM * ldb * 2; }
    __device__ bool next(int i, Unit& u) const {
        const long L = (long)i * G + c; if (L >= nwg) return false;
        int wgid = (int)L; { const int q = nwg / NXCD, r = nwg % NXCD, xcd = wgid % NXCD, off = wgid / NXCD; wgid = (xcd < r ? xcd * (q + 1) : r * (q + 1) + (xcd - r) * q) + off; }
        const int nig = WGM * nN, gid = wgid / nig, fm = gid * WGM, gsz = (nM - fm) < WGM ? (nM - fm) : WGM;
        u.pm = fm + ((wgid % nig) % gsz); u.pn = (wgid % nig) / gsz;
        if (mode == 0) { u.pa = A + (size_t)u.pm * tA; u.pb = B + (size_t)u.pn * tB; }
        else { const int g = u.pn >> 2, q = u.pn & 3; u.pa = A + (size_t)u.pm * tA + (size_t)g * 512; u.pb = B + (size_t)g * (1024ull * 256 * 2) + (size_t)q * tB; }
        return true;
    }
};

template <class Epi>
__device__ __forceinline__ void gemm_phase(LAS unsigned char* lds, int K, int lda, int ldb, const Sched& S, const Epi& E) {
    const int tid = otid(), wid = __builtin_amdgcn_readfirstlane(tid >> 6), lane = tid & 63, wr = wid >> 2, wc = wid & 3, fr = lane & 15, fq = lane >> 4;
    const int nt = K / BK;
    unsigned voffA[2], voffB[2];
#pragma unroll
    for (int i = 0; i < 2; ++i) { int R, C; stage_rc(tid * 16 + i * 8192, R, C); const int Rb = Epi::PERM ? ((R & ~31) + perm32(R & 31)) : R;
        voffA[i] = (unsigned)(R * lda + C) * 2u; voffB[i] = (unsigned)(Rb * ldb + C) * 2u; }
    const size_t kstep = (size_t)(BK * 2);
    const size_t hA = (size_t)HALF * lda * 2, hB = (size_t)HALF * ldb * 2;
    const unsigned ldsw = (unsigned)wid * 1024u;
    const int aoff = lds_byte(wr * 64 + fr, fq * 8), boff = lds_byte(wc * 32 + fr, fq * 8);
#define PG8_SA(b, h) (((b) * 2 + (h)) * HTB)
#define PG8_SB(b, h) ((4 + (b) * 2 + (h)) * HTB)
#define PG8_STAGE(bufoff, gbase, voff) do { const char* _ub = (const char*)(gbase); _Pragma("unroll") for (int _i = 0; _i < 2; ++_i) { unsigned _vo = (voff)[_i]; asm volatile("" : "+v"(_vo)); \
        __builtin_amdgcn_global_load_lds((const unsigned*)(_ub + _vo), (LAS unsigned*)(lds + (bufoff) + ldsw + _i * 8192), 16, 0, 0); } } while (0)
#define PG8_LDA(dst, b, h) do { _Pragma("unroll") for (int m = 0; m < 4; ++m) _Pragma("unroll") for (int k = 0; k < 2; ++k) dst[m][k] = *(const LAS bf16x8*)(lds + PG8_SA(b, h) + aoff + m * 2048 + k * 1024); } while (0)
#define PG8_LDB(dst, b, h) do { _Pragma("unroll") for (int n = 0; n < 2; ++n) _Pragma("unroll") for (int k = 0; k < 2; ++k) dst[n][k] = *(const LAS bf16x8*)(lds + PG8_SB(b, h) + boff + n * 2048 + k * 1024); } while (0)
#define PG8_MMA(ai, bj, At, Bt) do { __builtin_amdgcn_s_setprio(1); _Pragma("unroll") for (int m = 0; m < 4; ++m) _Pragma("unroll") for (int n = 0; n < 2; ++n) _Pragma("unroll") for (int k = 0; k < 2; ++k) \
        acc[ai][bj][m][n] = __builtin_amdgcn_mfma_f32_16x16x32_bf16(Bt[n][k], At[m][k], acc[ai][bj][m][n], 0, 0, 0); __builtin_amdgcn_s_setprio(0); } while (0)
#define PG8_WAIT_V(n) asm volatile("s_waitcnt vmcnt(" #n ")" ::: "memory")
#define PG8_WAIT_L(n) asm volatile("s_waitcnt lgkmcnt(" #n ")" ::: "memory")
#define PG8_BAR __builtin_amdgcn_s_barrier()
#define PG8_SCHED __builtin_amdgcn_sched_barrier(0)
    Unit cur, nxt; int ui = 0;
    if (!S.next(0, cur)) return;
    f32x4 acc[2][2][4][2];
#pragma unroll
    for (int a = 0; a < 2; ++a)
#pragma unroll
        for (int b = 0; b < 2; ++b)
#pragma unroll
            for (int m = 0; m < 4; ++m)
#pragma unroll
                for (int n = 0; n < 2; ++n) acc[a][b][m][n] = (f32x4){0.f, 0.f, 0.f, 0.f};
    bf16x8 At[4][2], B0[2][2], B1[2][2];
    const char* cA = cur.pa; const char* cB = cur.pb;
    PG8_STAGE(PG8_SB(0, 0), cB, voffB); PG8_STAGE(PG8_SA(0, 0), cA, voffA); PG8_STAGE(PG8_SB(0, 1), cB + hB, voffB); PG8_STAGE(PG8_SA(0, 1), cA + hA, voffA);
    if (wr == 1) PG8_BAR;
    PG8_WAIT_V(4); PG8_BAR;
    PG8_STAGE(PG8_SB(1, 0), cB + kstep, voffB); PG8_STAGE(PG8_SA(1, 0), cA + kstep, voffA); PG8_STAGE(PG8_SB(1, 1), cB + hB + kstep, voffB);
    PG8_WAIT_V(6); PG8_BAR;
    for (;;) {
        const bool has_next = S.next(ui + 1, nxt);
        const char* nA = has_next ? nxt.pa : cA; const char* nB = has_next ? nxt.pb : cB;
        for (int t = 0; t < nt; t += 2) {
            const bool last = (t == nt - 2);
            const char* a1 = cA + (size_t)(t + 1) * kstep;
            const char* a2 = last ? nA : cA + (size_t)(t + 2) * kstep; const char* b2 = last ? nB : cB + (size_t)(t + 2) * kstep;
            const char* a3 = a2 + kstep; const char* b3 = b2 + kstep;
            PG8_LDB(B0, 0, 0); PG8_SCHED; PG8_LDA(At, 0, 0); PG8_STAGE(PG8_SA(1, 1), a1 + hA, voffA);
            PG8_WAIT_L(8); PG8_BAR; PG8_WAIT_L(0); PG8_MMA(0, 0, At, B0); PG8_BAR; PG8_SCHED;
            PG8_LDB(B1, 0, 1); PG8_STAGE(PG8_SB(0, 0), b2, voffB);
            PG8_BAR; PG8_WAIT_L(0); PG8_MMA(0, 1, At, B1); PG8_BAR;
            PG8_LDA(At, 0, 1); PG8_STAGE(PG8_SA(0, 0), a2, voffA);
            PG8_BAR; PG8_WAIT_L(0); PG8_MMA(1, 0, At, B0); PG8_BAR; PG8_SCHED;
            PG8_STAGE(PG8_SB(0, 1), b2 + hB, voffB);
            PG8_WAIT_V(6); PG8_BAR; PG8_MMA(1, 1, At, B1); PG8_BAR;
            PG8_LDB(B0, 1, 0); PG8_SCHED; PG8_LDA(At, 1, 0); PG8_STAGE(PG8_SA(0, 1), a2 + hA, voffA);
            PG8_WAIT_L(8); PG8_BAR; PG8_WAIT_L(0); PG8_MMA(0, 0, At, B0); PG8_BAR; PG8_SCHED;
            PG8_LDB(B1, 1, 1); PG8_STAGE(PG8_SB(1, 0), b3, voffB);
            PG8_BAR; PG8_WAIT_L(0); PG8_MMA(0, 1, At, B1); PG8_BAR;
            PG8_LDA(At, 1, 1); PG8_STAGE(PG8_SA(1, 0), a3, voffA);
            PG8_BAR; PG8_WAIT_L(0); PG8_MMA(1, 0, At, B0); PG8_BAR; PG8_SCHED;
            PG8_STAGE(PG8_SB(1, 1), b3 + hB, voffB);
            PG8_WAIT_V(6); PG8_BAR; PG8_MMA(1, 1, At, B1); PG8_BAR;
        }
        E(acc, cur, wr, wc, fr, fq);
        if (!has_next) break;
#pragma unroll
        for (int a = 0; a < 2; ++a)
#pragma unroll
            for (int b = 0; b < 2; ++b)
#pragma unroll
                for (int m = 0; m < 4; ++m)
#pragma unroll
                    for (int n = 0; n < 2; ++n) acc[a][b][m][n] = (f32x4){0.f, 0.f, 0.f, 0.f};
        cur = nxt; cA = nA; cB = nB; ++ui;
    }
    PG8_WAIT_V(0);
    if (wr == 0) PG8_BAR;
    PG8_BAR;
#undef PG8_SA
#undef PG8_SB
#undef PG8_STAGE
#undef PG8_LDA
#undef PG8_LDB
#undef PG8_MMA
#undef PG8_WAIT_V
#undef PG8_WAIT_L
#undef PG8_BAR
#undef PG8_SCHED
}

typedef f32x4 Acc[2][2][4][2];
typedef unsigned long long ssq_t;
__device__ __forceinline__ float rstd_of(ssq_t q) { return rsqrtf((float)q * (1.0f / (1048576.0f * DM)) + EPS); }
__device__ __forceinline__ ssq_t ssq_fix(float sq) { return (ssq_t)(sq * 1048576.0f + 0.5f); }
struct EpiSwiglu {
    static constexpr bool PERM = true;
    bf16_t* O; const ssq_t* SS;
    __device__ __forceinline__ void operator()(const Acc& acc, const Unit& u, int wr, int wc, int fr, int fq) const {
        const int row0 = u.pm * BM + wr * 64 + fr, col0 = u.pn * 128 + wc * 32 + 8 * fq;
        ssq_t ssv[8];
#pragma unroll
        for (int i = 0; i < 8; ++i) ssv[i] = SS[row0 + (i >> 2) * HALF + (i & 3) * 16];
#pragma unroll
        for (int ai = 0; ai < 2; ++ai)
#pragma unroll
            for (int m = 0; m < 4; ++m) {
                const int r = row0 + ai * HALF + m * 16; const float rs = rstd_of(ssv[ai * 4 + m]);
                const f32x4 g0 = acc[ai][0][m][0] * rs, g1 = acc[ai][0][m][1] * rs, u0 = acc[ai][1][m][0] * rs, u1 = acc[ai][1][m][1] * rs;
                u32x4 w;
                w.x = cvt_pk_bf16(siluf_(g0[0]) * u0[0], siluf_(g0[1]) * u0[1]); w.y = cvt_pk_bf16(siluf_(g0[2]) * u0[2], siluf_(g0[3]) * u0[3]);
                w.z = cvt_pk_bf16(siluf_(g1[0]) * u1[0], siluf_(g1[1]) * u1[1]); w.w = cvt_pk_bf16(siluf_(g1[2]) * u1[2], siluf_(g1[3]) * u1[3]);
                *(u32x4*)(O + (size_t)r * FF + col0) = w;
            }
    }
};
struct EpiResid {
    static constexpr bool PERM = false;
    float* H; float alpha; bf16_t* HB; ssq_t* SS;
    __device__ __forceinline__ void operator()(const Acc& acc, const Unit& u, int wr, int wc, int fr, int fq) const {
        const int row0 = u.pm * BM + wr * 64 + fr, col0 = u.pn * BM + wc * 32 + 4 * fq;
#pragma unroll
        for (int ai = 0; ai < 2; ++ai) {
            f32x4 hv[4][2][2];
#pragma unroll
            for (int m = 0; m < 4; ++m) { const float* rowp = H + (size_t)(row0 + ai * HALF + m * 16) * DM + col0;
#pragma unroll
                for (int bj = 0; bj < 2; ++bj)
#pragma unroll
                    for (int n = 0; n < 2; ++n) hv[m][bj][n] = *(const f32x4*)(rowp + bj * HALF + n * 16); }
#pragma unroll
            for (int m = 0; m < 4; ++m) { const size_t r = (size_t)(row0 + ai * HALF + m * 16); float* rowp = H + r * DM + col0; bf16_t* hbp = HB + r * DM + col0; float sq = 0.f;
#pragma unroll
                for (int bj = 0; bj < 2; ++bj)
#pragma unroll
                    for (int n = 0; n < 2; ++n) { const f32x4 v = hv[m][bj][n] + acc[ai][bj][m][n] * alpha; *(f32x4*)(rowp + bj * HALF + n * 16) = v;
                        sq += (v[0] * v[0] + v[1] * v[1]) + (v[2] * v[2] + v[3] * v[3]);
                        u32x2 w; w.x = cvt_pk_bf16(v[0], v[1]); w.y = cvt_pk_bf16(v[2], v[3]); *(u32x2*)(hbp + bj * HALF + n * 16) = w; }
                sq += __shfl_xor(sq, 16); sq += __shfl_xor(sq, 32);
                if (fq == 0) __hip_atomic_fetch_add(SS + r, ssq_fix(sq), __ATOMIC_RELAXED, __HIP_MEMORY_SCOPE_AGENT); }
        }
    }
};
struct EpiBf16 {
    static constexpr bool PERM = true;
    bf16_t* O; int ldc; int ymode; bf16_t* vt; const ssq_t* SS;
    __device__ __forceinline__ void operator()(const Acc& acc, const Unit& u, int wr, int wc, int fr, int fq) const {
        const int row0 = u.pm * BM + wr * 64 + fr;
        if (vt != nullptr && u.pn == 2) {
#pragma unroll
            for (int ai = 0; ai < 2; ++ai)
#pragma unroll
                for (int m = 0; m < 4; ++m) { const int r = row0 + ai * HALF + m * 16; const int b = r / TT, t = r - b * TT;
                    const int pt = (t & ~15) + 8 * ((t >> 2) & 1) + 4 * ((t >> 3) & 1) + (t & 3); const float rs = rstd_of(SS[r]);
#pragma unroll
                    for (int bj = 0; bj < 2; ++bj) { const int c = bj * HALF + wc * 32 + 8 * fq; bf16_t* dst = vt + ((size_t)(b * 4 + (c >> 6)) * 64 + (c & 63)) * TT + pt;
#pragma unroll
                        for (int n = 0; n < 2; ++n)
#pragma unroll
                            for (int e = 0; e < 4; ++e) dst[(size_t)(4 * n + e) * TT] = f2bf(acc[ai][bj][m][n][e] * rs); } }
            return;
        }
        bf16_t* base = O; int colt = u.pn * BM;
        if (ymode) { base += (size_t)(u.pn >> 2) * HR * 1024; colt = (u.pn & 3) * BM; }
        const int col0 = colt + wc * 32 + 8 * fq;
        ssq_t ssv[8];
#pragma unroll
        for (int i = 0; i < 8; ++i) ssv[i] = SS ? SS[row0 + (i >> 2) * HALF + (i & 3) * 16] : 0ull;
#pragma unroll
        for (int ai = 0; ai < 2; ++ai)
#pragma unroll
            for (int m = 0; m < 4; ++m) { const int r = row0 + ai * HALF + m * 16; bf16_t* rowp = base + (size_t)r * ldc + col0; const float rs = SS ? rstd_of(ssv[ai * 4 + m]) : 1.0f;
#pragma unroll
                for (int bj = 0; bj < 2; ++bj) { const f32x4 v0 = acc[ai][bj][m][0] * rs, v1 = acc[ai][bj][m][1] * rs;
                    u32x4 w; w.x = cvt_pk_bf16(v0[0], v0[1]); w.y = cvt_pk_bf16(v0[2], v0[3]); w.z = cvt_pk_bf16(v1[0], v1[1]); w.w = cvt_pk_bf16(v1[2], v1[3]);
                    *(u32x4*)(rowp + bj * HALF) = w; } }
    }
};
struct EpiMlaUp {
    static constexpr bool PERM = false;
    bf16_t* Qm; bf16_t* Km; bf16_t* Vm;
    __device__ __forceinline__ void operator()(const Acc& acc, const Unit& u, int wr, int wc, int fr, int fq) const {
        const int row0 = u.pm * BM + wr * 64 + fr;
#pragma unroll
        for (int bj = 0; bj < 2; ++bj) {
            const int g32 = u.pn * 8 + bj * 4 + wc;
            if (g32 >= 28) continue;
            if (g32 < 12) {
                {
#pragma unroll
                    for (int ai = 0; ai < 2; ++ai)
#pragma unroll
                        for (int m = 0; m < 4; ++m) { const size_t r = (size_t)(row0 + ai * HALF + m * 16);
#pragma unroll
                            for (int n = 0; n < 2; ++n) { const f32x4 v = acc[ai][bj][m][n]; u32x2 w; w.x = cvt_pk_bf16(v[0], v[1]); w.y = cvt_pk_bf16(v[2], v[3]);
                                *(u32x2*)(Qm + r * 384 + g32 * 32 + n * 16 + 4 * fq) = w; } }
                }
            } else {
                const int cc = (g32 - 12) * 32, hh = cc >> 7, w_ = cc & 127;
                if (w_ < 64) {
                    bf16_t* dst = Km + hh * 96 + w_;
#pragma unroll
                    for (int ai = 0; ai < 2; ++ai)
#pragma unroll
                        for (int m = 0; m < 4; ++m) { const size_t r = (size_t)(row0 + ai * HALF + m * 16);
#pragma unroll
                            for (int n = 0; n < 2; ++n) { const f32x4 v = acc[ai][bj][m][n]; u32x2 w; w.x = cvt_pk_bf16(v[0], v[1]); w.y = cvt_pk_bf16(v[2], v[3]);
                                *(u32x2*)(dst + r * 384 + n * 16 + 4 * fq) = w; } }
                } else {
#pragma unroll
                    for (int ai = 0; ai < 2; ++ai)
#pragma unroll
                        for (int m = 0; m < 4; ++m) { const int r = row0 + ai * HALF + m * 16; const int b = r / TT, t = r - b * TT;
                            const int pt = (t & ~15) + 8 * ((t >> 2) & 1) + 4 * ((t >> 3) & 1) + (t & 3);
                            bf16_t* dst = Vm + ((size_t)(b * 4 + hh) * 64 + (w_ - 64) + 4 * fq) * TT + pt;
#pragma unroll
                            for (int n = 0; n < 2; ++n)
#pragma unroll
                                for (int e = 0; e < 4; ++e) dst[(size_t)(16 * n + e) * TT] = f2bf(acc[ai][bj][m][n][e]); }
                }
            }
        }
    }
};
struct EpiGate {
    static constexpr bool PERM = false;
    bf16_t* Mg; const bf16_t* Y; const float* bg; int rowoff; const ssq_t* SS;
    __device__ __forceinline__ void operator()(const Acc& acc, const Unit& u, int wr, int wc, int fr, int fq) const {
        const int row0 = u.pm * BM + wr * 64 + fr, colr = u.pn * 64 + wc * 16 + 4 * fq;
        f32x4 bv[4];
#pragma unroll
        for (int g = 0; g < 4; ++g) bv[g] = *(const f32x4*)(bg + g * 1024 + colr);
        ssq_t ssv[8];
#pragma unroll
        for (int i = 0; i < 8; ++i) ssv[i] = SS[rowoff + row0 + (i >> 2) * HALF + (i & 3) * 16];
#pragma unroll
        for (int ai = 0; ai < 2; ++ai) {
            u32x2 yv[4][4];
#pragma unroll
            for (int m = 0; m < 4; ++m)
#pragma unroll
                for (int g = 0; g < 4; ++g) yv[m][g] = *(const u32x2*)(Y + ((size_t)g * HR + row0 + ai * HALF + m * 16) * 1024 + colr);
#pragma unroll
            for (int m = 0; m < 4; ++m) { const int rl = row0 + ai * HALF + m * 16; const float rs = rstd_of(ssv[ai * 4 + m]);
                f32x4 s = (f32x4){0.f, 0.f, 0.f, 0.f};
#pragma unroll
                for (int bj = 0; bj < 2; ++bj)
#pragma unroll
                    for (int n = 0; n < 2; ++n) { const int g = 2 * bj + n; const f32x4 a = acc[ai][bj][m][n] * rs + bv[g];
                        const u32x2 y = yv[m][g];
                        s[0] += sigmoidf_(a[0]) * bflo(y.x); s[1] += sigmoidf_(a[1]) * bfhi(y.x); s[2] += sigmoidf_(a[2]) * bflo(y.y); s[3] += sigmoidf_(a[3]) * bfhi(y.y); }
                u32x2 w; w.x = cvt_pk_bf16(s[0], s[1]); w.y = cvt_pk_bf16(s[2], s[3]);
                *(u32x2*)(Mg + (size_t)(rowoff + rl) * 1024 + colr) = w; }
        }
    }
};
}

__device__ __forceinline__ int win_map(int m) {
    if (m < 768) return m;
    if (m < 1888) return m + 4;
    if (m < 2400) return m + 12;
    if (m < 2404) return m - 1632;
    if (m < 2412) return m - 512;
    return -1;
}
template <int job>
__device__ __forceinline__ float wfetch(const KP& p, int l, int n, int k) {
    if constexpr (job == 0 || job == 2) { const int pn = n >> 8, bj = (n >> 7) & 1, c = n & 127; const float* s = (job == 0 ? p.inp(3) : p.inp(28)) + (size_t)l * 1024 * 5632; return s[(size_t)k * 5632 + bj * FF + pn * 128 + c] * (job == 0 ? p.inp(2) : p.inp(27))[l * DM + k]; }
    else if constexpr (job == 1 || job == 3) { const float* s = (job == 1 ? p.inp(4) : p.inp(29)) + (size_t)l * FF * 1024; return s[(size_t)k * 1024 + n]; }
    else if constexpr (job == 4) { const int o = win_map(n); return o < 0 ? 0.f : p.inp(6)[(size_t)l * 1024 * 2412 + (size_t)k * 2412 + o] * p.inp(5)[l * DM + k]; }
    else if constexpr (job == 5) { const int pn = n >> 8, bj = (n >> 7) & 1, wc = (n >> 5) & 3, nn = (n >> 4) & 1, fq = (n >> 2) & 3, j = n & 3; const int g = 2 * bj + nn, col = 64 * pn + 16 * wc + 4 * fq + j;
              return p.inp(23)[((size_t)(l * 4 + g) * 1024 + k) * 1024 + col] * p.inp(5)[l * DM + k]; }
    else if constexpr (job == 6) { const int g = n >> 10, col = n & 1023; return p.inp(25)[((size_t)(l * 4 + g) * 256 + k) * 1024 + col]; }
    else if constexpr (job == 7) return p.inp(26)[(size_t)l * 1024 * 1024 + (size_t)k * 1024 + n];
    else {
        if (n < 384) return k < 192 ? p.inp(9)[(size_t)l * 192 * 384 + (size_t)k * 384 + n] : 0.f;
        if (n < 896) return (k >= 192 && k < 320) ? p.inp(11)[(size_t)l * 128 * 512 + (size_t)(k - 192) * 512 + (n - 384)] : 0.f;
        return 0.f; }
}
template <int job>
__device__ __forceinline__ void prep_job(const KP& p, LAS unsigned char* lds, int rot) {
    constexpr int jNp[9] = {5632, 1024, 5632, 1024, 2560, 4096, 4096, 1024, 1024};
    constexpr int jKp[9] = {1024, 2816, 1024, 2816, 1024, 1024, 256, 1024, 384};
    constexpr size_t jOff[9] = {W_WI1, W_WO1, W_WI2, W_WO2, W_WIN, W_WG, W_WB, W_WOUT, W_WUP};
    constexpr int Np = jNp[job], Kp = jKp[job], nkt = Kp / 64, cnt = (Np / 64) * nkt;
    const int tid = otid(), G = ogdim();
    LAS float* tile = (LAS float*)lds;
    for (int it = (obid() + rot) % G; it < 2 * cnt; it += G) {
        const int l = it / cnt, rr = it % cnt;
        const int n0 = (rr / nkt) * 64, k0 = (rr % nkt) * 64;
        const int nn = tid & 63, kk0 = tid >> 6;
#pragma unroll
        for (int i = 0; i < 8; ++i) { const int kk = kk0 + 8 * i; tile[kk * 65 + nn] = wfetch<job>(p, l, n0 + nn, k0 + kk); }
        __syncthreads();
        { const int n2 = tid >> 3, kg = tid & 7; float v[8];
#pragma unroll
          for (int e = 0; e < 8; ++e) v[e] = tile[(kg * 8 + e) * 65 + n2];
          u32x4 w; w.x = cvt_pk_bf16(v[0], v[1]); w.y = cvt_pk_bf16(v[2], v[3]); w.z = cvt_pk_bf16(v[4], v[5]); w.w = cvt_pk_bf16(v[6], v[7]);
          bf16_t* dst = (bf16_t*)(p.ws + OFF_W + (size_t)l * W_LAYER + jOff[job]);
          *(u32x4*)(dst + (size_t)(n0 + n2) * Kp + k0 + kg * 8) = w; }
        __syncthreads();
    }
}
__device__ __forceinline__ void phase_prep(const KP& p, LAS unsigned char* lds) {
    const int tid = otid();
    prep_job<0>(p, lds, 0); prep_job<1>(p, lds, 0); prep_job<2>(p, lds, 0); prep_job<3>(p, lds, 128); prep_job<4>(p, lds, 0);
    prep_job<5>(p, lds, 0); prep_job<6>(p, lds, 0); prep_job<7>(p, lds, 0); prep_job<8>(p, lds, 64);
    float* rope = (float*)(p.ws + OFF_ROPE);
    for (int i = obid() * NTHR + tid; i < TT * 16; i += ogdim() * NTHR) {
        const int t = i >> 4, f = i & 15;
        const float inv = powf(10000.0f, -(float)f * (1.0f / 16.0f));
        const float ang = (float)(t - PADL) * inv;
        rope[i] = cosf(ang); rope[TT * 16 + i] = sinf(ang);
    }
}

__device__ __forceinline__ void phase_rmsnorm(const KP& p, const float* g, int mode) {
    const int tid = otid(), wid = tid >> 6, lane = tid & 63;
    float* H = (float*)(p.ws + OFF_H); bf16_t* HB = (bf16_t*)(p.ws + OFF_UN); pg8::ssq_t* SS = (pg8::ssq_t*)(p.ws + OFF_SS);
    f32x4 gv[4];
#pragma unroll
    for (int i = 0; i < 4; ++i) gv[i] = (mode == 3) ? *(const f32x4*)(g + i * 256 + lane * 4) : (f32x4){0.f, 0.f, 0.f, 0.f};
    for (int row = obid() * 8 + wid; row < NT; row += ogdim() * 8) {
        const int b = row / TT, t = row % TT;
        if (mode == 3 && t < 128) continue;
        f32x4 v[4];
        if (mode == 2) {
            const float* src = t < PADL ? nullptr : (t < 128 ? p.inp(1) + (size_t)(t - PADL) * DM : p.inp(0) + ((size_t)b * 4096 + (t - 128)) * DM);
#pragma unroll
            for (int i = 0; i < 4; ++i) { v[i] = src ? *(const f32x4*)(src + i * 256 + lane * 4) : (f32x4){0.f, 0.f, 0.f, 0.f}; *(f32x4*)(H + (size_t)row * DM + i * 256 + lane * 4) = v[i];
                u32x2 w; w.x = cvt_pk_bf16(v[i][0], v[i][1]); w.y = cvt_pk_bf16(v[i][2], v[i][3]); *(u32x2*)(HB + (size_t)row * DM + i * 256 + lane * 4) = w; }
        } else {
#pragma unroll
            for (int i = 0; i < 4; ++i) v[i] = *(const f32x4*)(H + (size_t)row * DM + i * 256 + lane * 4);
        }
        float ss = 0.f;
#pragma unroll
        for (int i = 0; i < 4; ++i) ss += v[i][0] * v[i][0] + v[i][1] * v[i][1] + v[i][2] * v[i][2] + v[i][3] * v[i][3];
        ss = wave_sum(ss);
        if (mode == 2) { if (lane < 6) SS[(size_t)lane * NT + row] = lane == 0 ? pg8::ssq_fix(ss) : 0ull; }
        else {
            const float rstd = rsqrtf(ss * (1.0f / DM) + EPS);
            float* o = (float*)p.out + ((size_t)b * 4096 + (t - 128)) * DM;
#pragma unroll
            for (int i = 0; i < 4; ++i) *(f32x4*)(o + i * 256 + lane * 4) = v[i] * rstd * gv[i];
        }
    }
}

__device__ __forceinline__ void phase_mla_pre(const KP& p, int l) {
    const int tid = otid(), wid = tid >> 6, lane = tid & 63;
    const bf16_t* P = (const bf16_t*)(p.ws + OFF_BIG); bf16_t* A = (bf16_t*)(p.ws + OFF_AMLA); bf16_t* Km = (bf16_t*)(p.ws + OFF_KM);
    const float* rope = (const float*)(p.ws + OFF_ROPE);
    const float* gq = p.inp(8) + l * 192; const float* gkv = p.inp(10) + l * 128;
    const float gq0 = gq[lane], gq1 = gq[lane + 64], gq2 = gq[lane + 128], gk0 = gkv[lane], gk1 = gkv[lane + 64];
    for (int row = obid() * 8 + wid; row < NT; row += ogdim() * 8) {
        const bf16_t* pr = P + (size_t)row * PN; const int t = row % TT;
        const float c0 = bf2f(pr[PC_CQ + lane]), c1 = bf2f(pr[PC_CQ + 64 + lane]), c2 = bf2f(pr[PC_CQ + 128 + lane]);
        const float k0 = bf2f(pr[PC_CKV + lane]), k1 = bf2f(pr[PC_CKV + 64 + lane]);
        const float sq = wave_sum(c0 * c0 + c1 * c1 + c2 * c2), sk = wave_sum(k0 * k0 + k1 * k1);
        const float rq = rsqrtf(sq * (1.0f / 192.0f) + EPS), rk = rsqrtf(sk * (1.0f / 128.0f) + EPS);
        bf16_t* ar = A + (size_t)row * 384;
        ar[lane] = f2bf(c0 * rq * gq0); ar[lane + 64] = f2bf(c1 * rq * gq1); ar[lane + 128] = f2bf(c2 * rq * gq2);
        ar[192 + lane] = f2bf(k0 * rk * gk0); ar[256 + lane] = f2bf(k1 * rk * gk1); ar[320 + lane] = 0;
        if (lane < 16) {
            const float x1 = bf2f(pr[PC_KR + lane]), x2 = bf2f(pr[PC_KR + 16 + lane]);
            const float cs = rope[t * 16 + lane], sn = rope[TT * 16 + t * 16 + lane];
            const bf16_t o1 = f2bf(x1 * cs - x2 * sn), o2 = f2bf(x2 * cs + x1 * sn);
            bf16_t* kr = Km + (size_t)row * 384;
#pragma unroll
            for (int hh = 0; hh < 4; ++hh) { kr[hh * 96 + 64 + lane] = o1; kr[hh * 96 + 80 + lane] = o2; }
        }
    }
}
__device__ __forceinline__ void fox_cum_item(const KP& p, int l, LAS unsigned char* lds, int bh) {
    const int tid = otid(), wid = tid >> 6, lane = tid & 63;
    const int b = bh >> 2, h = bh & 3;
    const bf16_t* P = (const bf16_t*)(p.ws + OFF_BIG) + (size_t)b * TT * PN + PC_FF + h; float* cum = (float*)(p.ws + OFF_CUM) + (size_t)bh * TT;
    const float bf = p.inp(7)[l * 4 + h];
    LAS float* wtot = (LAS float*)lds;
    float v[9]; float run = 0.f;
#pragma unroll
    for (int e = 0; e < 9; ++e) { const int t = tid * 9 + e; float x = 0.f;
        if (t >= PADL && t < TT) { const float z = bf2f(P[(size_t)t * PN]) + bf; x = fminf(z, 0.f) - log1pf(expf(-fabsf(z))); }
        run += x; v[e] = run; }
    float inc = run;
#pragma unroll
    for (int o = 1; o < 64; o <<= 1) { const float u = __shfl_up(inc, o); if (lane >= o) inc += u; }
    __syncthreads();
    if (lane == 63) wtot[wid] = inc;
    __syncthreads();
    float off = inc - run;
#pragma unroll
    for (int w = 0; w < 8; ++w) if (w < wid) off += wtot[w];
#pragma unroll
    for (int e = 0; e < 9; ++e) { const int t = tid * 9 + e; if (t < TT) cum[t] = (off + v[e]) * LOG2E; }
    __syncthreads();
}

constexpr int GS = 72;
template <bool SWAP>
__device__ __forceinline__ f32x4 mma_nt(const LAS bf16_t* A, const LAS bf16_t* B, int ti, int tj, int lane, f32x4 acc) {
    const int fr = lane & 15, fq = lane >> 4;
#pragma unroll
    for (int ks = 0; ks < 2; ++ks) {
        const bf16x8 a = *(const LAS bf16x8*)(A + (ti * 16 + fr) * GS + ks * 32 + fq * 8);
        const bf16x8 b = *(const LAS bf16x8*)(B + (tj * 16 + fr) * GS + ks * 32 + fq * 8);
        acc = SWAP ? __builtin_amdgcn_mfma_f32_16x16x32_bf16(b, a, acc, 0, 0, 0) : __builtin_amdgcn_mfma_f32_16x16x32_bf16(a, b, acc, 0, 0, 0);
    }
    return acc;
}

__device__ __forceinline__ void lru_item(const KP& p, int l, LAS unsigned char* lds, int item) {
    const int tid = otid(), wid = tid >> 6, lane = tid & 63, j = tid & 63, tq = tid >> 6, fr = lane & 15, fq = lane >> 4;
    const int b = item >> 2, n = item & 3, c = n * 64 + j;
    const bf16_t* P = (const bf16_t*)(p.ws + OFF_BIG) + (size_t)b * TT * PN + PC_LRU + c;
    bf16_t* YS = (bf16_t*)(p.out + OO_YS) + (size_t)b * TT * 1024 + 768 + n * 64;
    LAS float* xs = (LAS float*)lds;
    LAS float* as = xs + 4096;
    LAS float* bs = as + 4096;
    LAS bf16_t* Xb = (LAS bf16_t*)(bs + 4096);
    LAS bf16_t* WaT = Xb + 64 * GS;
    LAS bf16_t* WxT = WaT + 64 * GS;
    LAS float* segA = (LAS float*)(WxT + 64 * GS);
    LAS float* segH = segA + 512;
    const float* cw = p.inp(16) + (size_t)l * 4 * 256;
    const float w0 = cw[c], w1 = cw[256 + c], w2 = cw[512 + c], w3 = cw[768 + c], cb = p.inp(17)[l * 256 + c];
    __syncthreads();
    { const float* WA = p.inp(18) + ((size_t)(l * 4 + n)) * 4096; const float* WX = p.inp(20) + ((size_t)(l * 4 + n)) * 4096;
      for (int e = tid; e < 4096; e += NTHR) { const int i = e >> 6, jj = e & 63; WaT[jj * GS + i] = f2bf(WA[e]); WxT[jj * GS + i] = f2bf(WX[e]); } }
    for (int e = tid; e < 64 * 64; e += NTHR) YS[(size_t)(e >> 6) * 1024 + (e & 63)] = 0;
    float gba[2], gbx[2], gc[2];
#pragma unroll
    for (int q = 0; q < 2; ++q) { const int ch = n * 64 + ((wid * 2 + q) & 3) * 16 + fr;
        gba[q] = p.inp(19)[l * 256 + ch]; gbx[q] = p.inp(21)[l * 256 + ch]; gc[q] = -8.0f * log1pf(expf(-p.inp(22)[l * 256 + ch])); }
    float hst = 0.f;
    bf16_t xr_[11];
#define LRU_LOAD(t0_) do { const int tb_ = (t0_) + tq * 8; _Pragma("unroll") for (int e = 0; e < 11; ++e) xr_[e] = P[(size_t)(tb_ - 3 + e) * PN]; } while (0)
    LRU_LOAD(64);
    for (int t0 = 64; t0 < TT; t0 += 64) {
        {
            float x[11];
#pragma unroll
            for (int e = 0; e < 11; ++e) x[e] = bf2f(xr_[e]);
#pragma unroll
            for (int e = 0; e < 8; ++e) { float xr = cb + w0 * x[e] + w1 * x[e + 1] + w2 * x[e + 2] + w3 * x[e + 3]; if (t0 + tq * 8 + e < PADL) xr = 0.f;
                xs[(tq * 8 + e) * 64 + j] = xr; Xb[(tq * 8 + e) * GS + j] = f2bf(xr); }
        }
        if (t0 + 64 < TT) LRU_LOAD(t0 + 64);
        __syncthreads();
#pragma unroll
        for (int q = 0; q < 2; ++q) { const int tile = wid * 2 + q, ti = tile >> 2, tj = tile & 3;
            const f32x4 ca = mma_nt<false>(Xb, WaT, ti, tj, lane, (f32x4){0.f, 0.f, 0.f, 0.f});
            const f32x4 cx = mma_nt<false>(Xb, WxT, ti, tj, lane, (f32x4){0.f, 0.f, 0.f, 0.f});
#pragma unroll
            for (int e = 0; e < 4; ++e) { const int idx = (ti * 16 + 4 * fq + e) * 64 + tj * 16 + fr;
                const float r = sigmoidf_(ca[e] + gba[q]), ig = sigmoidf_(cx[e] + gbx[q]);
                const float la = gc[q] * r, x2 = 2.0f * la;
                const float om = (x2 > -0.25f) ? -x2 * (1.0f + x2 * (0.5f + x2 * (0.16666667f + x2 * (0.041666668f + x2 * (0.0083333338f + x2 * 0.0013888889f))))) : 1.0f - __expf(x2);
                as[idx] = __expf(la); bs[idx] = __builtin_sqrtf(om) * ig * xs[idx]; }
        }
        __syncthreads();
        {
            float hl[8], pl[8]; float P = 1.0f, Hh = 0.f;
#pragma unroll
            for (int e = 0; e < 8; ++e) { const float a = as[(wid * 8 + e) * 64 + lane], bb = bs[(wid * 8 + e) * 64 + lane]; Hh = a * Hh + bb; P *= a; hl[e] = Hh; pl[e] = P; }
            segA[wid * 64 + lane] = P; segH[wid * 64 + lane] = Hh;
            __syncthreads();
            float carry = hst, full = hst;
#pragma unroll
            for (int w = 0; w < 8; ++w) { const float sa = segA[w * 64 + lane], sh = segH[w * 64 + lane]; full = sa * full + sh; if (w < wid) carry = full; }
            hst = full;
#pragma unroll
            for (int e = 0; e < 8; ++e) YS[(size_t)(t0 + wid * 8 + e) * 1024 + lane] = f2bf(hl[e] + pl[e] * carry);
        }
    }
#undef LRU_LOAD
    __syncthreads();
}

__device__ __forceinline__ void gdn_gates_v(float araw, float braw, float A, float dtb, int lane, LAS float* betas, LAS float* Gs) {
    const float z = araw + dtb; const float spz = fmaxf(z, 0.f) + log1pf(expf(-fabsf(z)));
    float g = -A * spz;
#pragma unroll
    for (int o = 1; o < 64; o <<= 1) { const float u = __shfl_up(g, o); if (lane >= o) g += u; }
    betas[lane] = 1.0f / (1.0f + expf(-braw)); Gs[lane] = g;
}

__device__ __forceinline__ void gdn_pre_pair(const KP& p, int l, LAS unsigned char* lds, int pair) {
    const int tid = otid(), hf = tid >> 8, lt = tid & 255, wl = lt >> 6, lane = tid & 63, fr = lane & 15, fq = lane >> 4;
    const int cid = pair * 2 + hf, n = cid % 66, bh = cid / 66, b = bh >> 2, h = bh & 3, t0 = n * 64;
    const bool act = n != 0;
    bf16_t* GW = (bf16_t*)(p.out + OO_GW) + (size_t)cid * 4096; bf16_t* GU = (bf16_t*)(p.out + OO_GU) + (size_t)cid * 4096;
    LAS float* Kf = (LAS float*)(lds + hf * 61440);
    LAS float* Vf = Kf + 4096;
    LAS float* Mm = Vf + 4096;
    LAS float* betas = Mm + 4096; LAS float* Gs = betas + 64;
    LAS bf16_t* Kc = (LAS bf16_t*)(Gs + 64);
    const bf16_t* Pb = (const bf16_t*)(p.ws + OFF_BIG) + (size_t)b * TT * PN;
    const float* cw = p.inp(12) + (size_t)l * 4 * 768;
    __syncthreads();
    if (act) {
        const int ch = lt & 63, tq = lt >> 6, tb = t0 + tq * 16;
#pragma unroll
        for (int kv = 0; kv < 2; ++kv) {
            const bf16_t* P = Pb + (kv ? PC_GV : PC_GK) + h * 64 + ch; const float* w = cw + (kv ? 512 : 256) + h * 64 + ch; LAS float* dst = kv ? Vf : Kf;
            const float w0 = w[0], w1 = w[768], w2 = w[1536], w3 = w[2304];
            float x[19];
#pragma unroll
            for (int e = 0; e < 19; ++e) x[e] = bf2f(P[(size_t)(tb - 3 + e) * PN]);
#pragma unroll
            for (int e = 0; e < 16; ++e) dst[(tq * 16 + e) * 64 + ch] = siluf_(w0 * x[e] + w1 * x[e + 1] + w2 * x[e + 2] + w3 * x[e + 3]);
        }
        if (wl == 0) { const bf16_t* pr = Pb + (size_t)(t0 + lane) * PN;
            gdn_gates_v(bf2f(pr[PC_GA + h]), bf2f(pr[PC_GB + h]), expf(p.inp(13)[l * 4 + h]), p.inp(14)[l * 4 + h], lane, betas, Gs); }
    }
    __syncthreads();
    if (act) {
        const int row = lt >> 2, seg = lt & 3; float v[16]; float ss = 0.f;
#pragma unroll
        for (int e = 0; e < 16; ++e) { v[e] = Kf[row * 64 + seg * 16 + e]; ss += v[e] * v[e]; }
        ss += __shfl_xor(ss, 1); ss += __shfl_xor(ss, 2);
        const float rs = rsqrtf(ss + EPS);
#pragma unroll
        for (int e = 0; e < 16; ++e) { v[e] *= rs; Kf[row * 64 + seg * 16 + e] = v[e]; }
#pragma unroll
        for (int q = 0; q < 2; ++q) { u32x4 w; w.x = cvt_pk_bf16(v[8 * q], v[8 * q + 1]); w.y = cvt_pk_bf16(v[8 * q + 2], v[8 * q + 3]); w.z = cvt_pk_bf16(v[8 * q + 4], v[8 * q + 5]); w.w = cvt_pk_bf16(v[8 * q + 6], v[8 * q + 7]);
            *(LAS u32x4*)(Kc + row * GS + seg * 16 + q * 8) = w; }
    }
    __syncthreads();
    if (act) {
#pragma unroll
        for (int q = 0; q < 4; ++q) { const int tile = wl * 4 + q, ti = tile >> 2, tj = tile & 3;
            const f32x4 d = mma_nt<false>(Kc, Kc, ti, tj, lane, (f32x4){0.f, 0.f, 0.f, 0.f});
            const int j = tj * 16 + fr, i0 = ti * 16 + 4 * fq; const float gj = Gs[j];
            f32x4 o;
#pragma unroll
            for (int e = 0; e < 4; ++e) { const int i = i0 + e; o[e] = (i > j) ? betas[i] * d[e] * __expf(Gs[i] - gj) : 0.f; }
            *(LAS f32x4*)(Mm + j * 64 + i0) = o; }
    }
    __syncthreads();
    if (act && lt < 128) {
        const int col = lt & 63; const bool isw = lt < 64;
        float s[64];
#pragma unroll
        for (int i = 0; i < 64; ++i) s[i] = isw ? Kf[i * 64 + col] * betas[i] * __expf(Gs[i]) : Vf[i * 64 + col] * betas[i];
#pragma unroll
        for (int j = 0; j < 63; ++j) {
            const float sj = s[j];
#pragma unroll
            for (int i4 = (j + 1) / 4; i4 < 16; ++i4) { const f32x4 mv = *(const LAS f32x4*)(Mm + j * 64 + i4 * 4);
#pragma unroll
                for (int e = 0; e < 4; ++e) if (i4 * 4 + e > j) s[i4 * 4 + e] -= mv[e] * sj; }
        }
        if (isw) {
#pragma unroll
            for (int i = 0; i < 64; ++i) GW[i * 64 + col] = f2bf(s[i]);
        } else {
#pragma unroll
            for (int q = 0; q < 8; ++q) { u32x4 w; w.x = cvt_pk_bf16(s[q * 8], s[q * 8 + 1]); w.y = cvt_pk_bf16(s[q * 8 + 2], s[q * 8 + 3]); w.z = cvt_pk_bf16(s[q * 8 + 4], s[q * 8 + 5]); w.w = cvt_pk_bf16(s[q * 8 + 6], s[q * 8 + 7]);
                *(u32x4*)(GU + col * 64 + q * 8) = w; }
        }
    }
}

__device__ __forceinline__ void gdn_scan_item(const KP& p, int l, LAS unsigned char* lds, int bh) {
    const int tid = otid(), wid = tid >> 6, lane = tid & 63, fr = lane & 15, fq = lane >> 4;
    const int b = bh >> 2, h = bh & 3;
    LAS float* Qf = (LAS float*)lds;
    LAS float* Kf = Qf + 4096;
    LAS float* betas = Kf + 4096; LAS float* Gs = betas + 64;
    LAS bf16_t* Qc = (LAS bf16_t*)(Gs + 64);
    LAS bf16_t* Kc = Qc + 64 * GS; LAS bf16_t* QD = Kc + 64 * GS; LAS bf16_t* KDT = QD + 64 * GS; LAS bf16_t* QK = KDT + 64 * GS;
    LAS bf16_t* Wc = QK + 64 * GS; LAS bf16_t* ST = Wc + 64 * GS; LAS bf16_t* VNT = ST + 64 * GS; LAS bf16_t* UT = VNT + 64 * GS;
    const bf16_t* Pb = (const bf16_t*)(p.ws + OFF_BIG) + (size_t)b * TT * PN;
    const float* cw = p.inp(12) + (size_t)l * 4 * 768;
    bf16_t* YS = (bf16_t*)(p.out + OO_YS) + (size_t)b * TT * 1024 + 512 + h * 64;
    const float* gon = p.inp(15) + l * 64;
    const int ch = tid & 63, tq = tid >> 6, row = tid >> 3, seg = tid & 7;
    const float wq0 = cw[h * 64 + ch], wq1 = cw[768 + h * 64 + ch], wq2 = cw[1536 + h * 64 + ch], wq3 = cw[2304 + h * 64 + ch];
    const float wk0 = cw[256 + h * 64 + ch], wk1 = cw[768 + 256 + h * 64 + ch], wk2 = cw[1536 + 256 + h * 64 + ch], wk3 = cw[2304 + 256 + h * 64 + ch];
    const float Adec = expf(p.inp(13)[l * 4 + h]), dtb = p.inp(14)[l * 4 + h];
    const bf16_t* Pq = Pb + PC_GQ + h * 64 + ch; const bf16_t* Pk = Pb + PC_GK + h * 64 + ch;
    const bf16_t* GWb = (const bf16_t*)(p.out + OO_GW) + (size_t)bh * 66 * 4096 + row * 64 + seg * 8;
    const bf16_t* GUb = (const bf16_t*)(p.out + OO_GU) + (size_t)bh * 66 * 4096 + row * 64 + seg * 8;
    __syncthreads();
    for (int e = tid; e < 64 * GS / 2; e += NTHR) ((LAS unsigned*)ST)[e] = 0u;
    for (int e = tid; e < 64 * 16; e += NTHR) *(u32x2*)(YS + (size_t)(e >> 4) * 1024 + (e & 15) * 4) = (u32x2){0u, 0u};
    f32x4 Sacc[2] = {(f32x4){0.f, 0.f, 0.f, 0.f}, (f32x4){0.f, 0.f, 0.f, 0.f}};
    bf16_t xq[11], xk[11]; u32x4 wreg, ureg; bf16_t araw = 0, braw = 0; u32x2 ggn[4], ggc[4];
#pragma unroll
    for (int tv = 0; tv < 4; ++tv) { ggn[tv] = (u32x2){0u, 0u}; ggc[tv] = (u32x2){0u, 0u}; }
#define GDN_LOAD(n_) do { const int t0_ = (n_) * 64, tb_ = t0_ + tq * 8; \
        _Pragma("unroll") for (int e = 0; e < 11; ++e) { xq[e] = Pq[(size_t)(tb_ - 3 + e) * PN]; xk[e] = Pk[(size_t)(tb_ - 3 + e) * PN]; } \
        wreg = *(const u32x4*)(GWb + (size_t)(n_) * 4096); ureg = *(const u32x4*)(GUb + (size_t)(n_) * 4096); \
        if (wid == 0) { const bf16_t* pr_ = Pb + (size_t)(t0_ + lane) * PN; araw = pr_[PC_GA + h]; braw = pr_[PC_GB + h]; } \
        if (wid < 4) { const bf16_t* gp_ = Pb + (size_t)(t0_ + wid * 16 + fr) * PN + PC_GG + h * 64 + 4 * fq; \
            _Pragma("unroll") for (int tv = 0; tv < 4; ++tv) ggn[tv] = *(const u32x2*)(gp_ + tv * 16); } } while (0)
    f32x4 gnv[4];
#pragma unroll
    for (int tv = 0; tv < 4; ++tv) gnv[tv] = *(const f32x4*)(gon + tv * 16 + 4 * fq);
    GDN_LOAD(1);
    for (int n = 1; n < 66; ++n) {
        const int t0 = n * 64;
        {
            float x[11];
#pragma unroll
            for (int e = 0; e < 11; ++e) x[e] = bf2f(xq[e]);
#pragma unroll
            for (int e = 0; e < 8; ++e) Qf[(tq * 8 + e) * 64 + ch] = siluf_(wq0 * x[e] + wq1 * x[e + 1] + wq2 * x[e + 2] + wq3 * x[e + 3]);
#pragma unroll
            for (int e = 0; e < 11; ++e) x[e] = bf2f(xk[e]);
#pragma unroll
            for (int e = 0; e < 8; ++e) Kf[(tq * 8 + e) * 64 + ch] = siluf_(wk0 * x[e] + wk1 * x[e + 1] + wk2 * x[e + 2] + wk3 * x[e + 3]);
            if (wid == 0) gdn_gates_v(bf2f(araw), bf2f(braw), Adec, dtb, lane, betas, Gs);
            *(LAS u32x4*)(Wc + row * GS + seg * 8) = wreg; *(LAS u32x4*)(UT + row * GS + seg * 8) = ureg;
#pragma unroll
            for (int tv = 0; tv < 4; ++tv) ggc[tv] = ggn[tv];
        }
        if (n + 1 < 66) GDN_LOAD(n + 1);
        __syncthreads();
        {
            float q[8], k[8]; float sq = 0.f, sk = 0.f;
#pragma unroll
            for (int e = 0; e < 8; ++e) { q[e] = Qf[row * 64 + seg * 8 + e]; k[e] = Kf[row * 64 + seg * 8 + e]; sq += q[e] * q[e]; sk += k[e] * k[e]; }
            sq += __shfl_xor(sq, 1); sq += __shfl_xor(sq, 2); sq += __shfl_xor(sq, 4);
            sk += __shfl_xor(sk, 1); sk += __shfl_xor(sk, 2); sk += __shfl_xor(sk, 4);
            const float rq = rsqrtf(sq + EPS) * 0.125f, rk = rsqrtf(sk + EPS);
            const float g = Gs[row], eg = __expf(g), ekd = __expf(Gs[63] - g);
#pragma unroll
            for (int e = 0; e < 8; ++e) { q[e] *= rq; k[e] *= rk; }
            u32x4 w; w.x = cvt_pk_bf16(q[0], q[1]); w.y = cvt_pk_bf16(q[2], q[3]); w.z = cvt_pk_bf16(q[4], q[5]); w.w = cvt_pk_bf16(q[6], q[7]);
            *(LAS u32x4*)(Qc + row * GS + seg * 8) = w;
            w.x = cvt_pk_bf16(q[0] * eg, q[1] * eg); w.y = cvt_pk_bf16(q[2] * eg, q[3] * eg); w.z = cvt_pk_bf16(q[4] * eg, q[5] * eg); w.w = cvt_pk_bf16(q[6] * eg, q[7] * eg);
            *(LAS u32x4*)(QD + row * GS + seg * 8) = w;
            w.x = cvt_pk_bf16(k[0], k[1]); w.y = cvt_pk_bf16(k[2], k[3]); w.z = cvt_pk_bf16(k[4], k[5]); w.w = cvt_pk_bf16(k[6], k[7]);
            *(LAS u32x4*)(Kc + row * GS + seg * 8) = w;
#pragma unroll
            for (int e = 0; e < 8; ++e) KDT[(seg * 8 + e) * GS + row] = f2bf(k[e] * ekd);
        }
        __syncthreads();
        {
#pragma unroll
            for (int q = 0; q < 2; ++q) { const int tile = wid * 2 + q, ti = tile >> 2, tj = tile & 3;
                const f32x4 d = mma_nt<true>(Qc, Kc, ti, tj, lane, (f32x4){0.f, 0.f, 0.f, 0.f});
                const int i = ti * 16 + fr, j0 = tj * 16 + 4 * fq; const float gi = Gs[i];
                float o[4];
#pragma unroll
                for (int e = 0; e < 4; ++e) { const int jj = j0 + e; o[e] = (i >= jj) ? d[e] * __expf(gi - Gs[jj]) : 0.f; }
                u32x2 w; w.x = cvt_pk_bf16(o[0], o[1]); w.y = cvt_pk_bf16(o[2], o[3]);
                *(LAS u32x2*)(QK + i * GS + j0) = w; }
#pragma unroll
            for (int q = 0; q < 2; ++q) { const int tile = wid * 2 + q, ti = tile >> 2, tj = tile & 3;
                const f32x4 d = mma_nt<false>(Wc, ST, ti, tj, lane, (f32x4){0.f, 0.f, 0.f, 0.f});
                const int dv = tj * 16 + fr, c0 = ti * 16 + 4 * fq;
                const u32x2 uu = *(const LAS u32x2*)(UT + dv * GS + c0);
                u32x2 w; w.x = cvt_pk_bf16(bflo(uu.x) - d[0], bfhi(uu.x) - d[1]); w.y = cvt_pk_bf16(bflo(uu.y) - d[2], bfhi(uu.y) - d[3]);
                *(LAS u32x2*)(VNT + dv * GS + c0) = w; }
        }
        __syncthreads();
        {
            const float gl = __expf(Gs[63]);
            if (wid < 4) {
                f32x4 o[4];
#pragma unroll
                for (int tv = 0; tv < 4; ++tv) { o[tv] = mma_nt<true>(QD, ST, wid, tv, lane, (f32x4){0.f, 0.f, 0.f, 0.f}); o[tv] = mma_nt<true>(QK, VNT, wid, tv, lane, o[tv]); }
                float ss = 0.f;
#pragma unroll
                for (int tv = 0; tv < 4; ++tv) ss += o[tv][0] * o[tv][0] + o[tv][1] * o[tv][1] + o[tv][2] * o[tv][2] + o[tv][3] * o[tv][3];
                ss += __shfl_xor(ss, 16); ss += __shfl_xor(ss, 32);
                const float rs = rsqrtf(ss * (1.0f / 64.0f) + EPS);
                const int t = t0 + wid * 16 + fr;
#pragma unroll
                for (int tv = 0; tv < 4; ++tv) { const int dv = tv * 16 + 4 * fq;
                    const u32x2 gg = ggc[tv]; const f32x4 gn = gnv[tv];
                    u32x2 w; w.x = cvt_pk_bf16(o[tv][0] * rs * gn[0] * siluf_(bflo(gg.x)), o[tv][1] * rs * gn[1] * siluf_(bfhi(gg.x)));
                    w.y = cvt_pk_bf16(o[tv][2] * rs * gn[2] * siluf_(bflo(gg.y)), o[tv][3] * rs * gn[3] * siluf_(bfhi(gg.y)));
                    if (t < PADL) { w.x = 0u; w.y = 0u; }
                    *(u32x2*)(YS + (size_t)t * 1024 + dv) = w; }
            }
#pragma unroll
            for (int q = 0; q < 2; ++q) { const int tile = wid * 2 + q, ti = tile >> 2, tj = tile & 3;
                Sacc[q] = mma_nt<false>(KDT, VNT, ti, tj, lane, Sacc[q] * gl); }
        }
        __syncthreads();
#pragma unroll
        for (int q = 0; q < 2; ++q) { const int tile = wid * 2 + q, ti = tile >> 2, tj = tile & 3;
            u32x2 w; w.x = cvt_pk_bf16(Sacc[q][0], Sacc[q][1]); w.y = cvt_pk_bf16(Sacc[q][2], Sacc[q][3]);
            *(LAS u32x2*)(ST + (tj * 16 + fr) * GS + ti * 16 + 4 * fq) = w; }
    }
#undef GDN_LOAD
    __syncthreads();
}

__device__ __forceinline__ int vt_pos(int t) { return (t & ~15) + 8 * ((t >> 2) & 1) + 4 * ((t >> 3) & 1) + (t & 3); }
template <int DK, bool FOX>
__device__ __forceinline__ void attn_item(LAS unsigned char* lds, const bf16_t* Qp, int ldq, const bf16_t* Kp, int ldk, const bf16_t* Vp  ,
                          const float* cum2, const float* rope, float c1, bf16_t* Op, int qt) {
    constexpr int KST = DK + 8, NDS = DK / 16, KPIECES = 64 * DK / 8, BUFB = 64 * KST * 2 + 64 * 72 * 2 + 256;
    const int tid = otid(), wid = tid >> 6, lane = tid & 63, qi = lane & 31, half = lane >> 5;
    const int q0 = qt * 256 + wid * 32, tq = q0 + qi;
    const bool wact = q0 < TT;
    bf16x8 qf[NDS];
#pragma unroll
    for (int ds = 0; ds < NDS; ++ds) qf[ds] = (tq < TT) ? *(const bf16x8*)(Qp + (size_t)tq * ldq + ds * 16 + 8 * half) : (bf16x8){0, 0, 0, 0, 0, 0, 0, 0};
    if (!FOX) {
        const int tr = tq < TT ? tq : TT - 1;
        const float* cs = rope + tr * 16 + 8 * half; const float* sn = rope + TT * 16 + tr * 16 + 8 * half;
        u32x4 a = *(u32x4*)&qf[NDS - 2], b = *(u32x4*)&qf[NDS - 1];
        unsigned aw[4] = {a.x, a.y, a.z, a.w}, bw[4] = {b.x, b.y, b.z, b.w};
#pragma unroll
        for (int e = 0; e < 4; ++e) { const float c0 = cs[2 * e], c1_ = cs[2 * e + 1], s0_ = sn[2 * e], s1_ = sn[2 * e + 1];
            const float x1l = bflo(aw[e]), x1h = bfhi(aw[e]), x2l = bflo(bw[e]), x2h = bfhi(bw[e]);
            aw[e] = cvt_pk_bf16(x1l * c0 - x2l * s0_, x1h * c1_ - x2h * s1_); bw[e] = cvt_pk_bf16(x2l * c0 + x1l * s0_, x2h * c1_ + x1h * s1_); }
        a = (u32x4){aw[0], aw[1], aw[2], aw[3]}; b = (u32x4){bw[0], bw[1], bw[2], bw[3]};
        qf[NDS - 2] = *(bf16x8*)&a; qf[NDS - 1] = *(bf16x8*)&b;
    }
    const float cq = FOX ? cum2[tq < TT ? tq : TT - 1] : 0.f;
    f32x16 o0, o1;
#pragma unroll
    for (int r = 0; r < 16; ++r) { o0[r] = 0.f; o1[r] = 0.f; }
    float mrow = -1e30f, lrow = 0.f;
    const int jmax = (4 * qt + 3) < 65 ? (4 * qt + 3) : 65;
    const int jw = (q0 + 31) >> 6;
    u32x4 kr0, kr1, vr; float cr = 0.f;
    const int kkey0 = tid / (DK / 8), kseg0 = tid % (DK / 8), kkey1 = (tid + 512) / (DK / 8), kseg1 = (tid + 512) % (DK / 8);
    const int vd = tid >> 3, vseg = tid & 7;
#define ATT_PREFETCH(j) do { const size_t kb_ = (size_t)(j) * 64; \
        kr0 = *(const u32x4*)(Kp + (kb_ + kkey0) * ldk + kseg0 * 8); \
        if (KPIECES > 512 && tid + 512 < KPIECES) kr1 = *(const u32x4*)(Kp + (kb_ + kkey1) * ldk + kseg1 * 8); \
        vr = *(const u32x4*)(Vp + (size_t)vd * TT + kb_ + vseg * 8); \
        if (FOX && tid < 64) cr = cum2[kb_ + tid]; } while (0)
#define ATT_WRITE(buf) do { LAS bf16_t* Ks_ = (LAS bf16_t*)(lds + (buf) * BUFB); LAS bf16_t* Vt_ = Ks_ + 64 * KST; \
        *(LAS u32x4*)(Ks_ + kkey0 * KST + kseg0 * 8) = kr0; \
        if (KPIECES > 512 && tid + 512 < KPIECES) *(LAS u32x4*)(Ks_ + kkey1 * KST + kseg1 * 8) = kr1; \
        *(LAS u32x4*)(Vt_ + vd * 72 + vseg * 8) = vr; \
        if (FOX && tid < 64) ((LAS float*)(Vt_ + 64 * 72))[tid] = cr; } while (0)
    kr1 = (u32x4){0u, 0u, 0u, 0u};
    __syncthreads();
    ATT_PREFETCH(1);
    ATT_WRITE(1);
    if (2 <= jmax) ATT_PREFETCH(2);
    __syncthreads();
    for (int j = 1; j <= jmax; ++j) {
        if (j + 1 <= jmax) ATT_WRITE((j + 1) & 1);
        if (j + 2 <= jmax) ATT_PREFETCH(j + 2);
        if (wact && j <= jw) {
            const LAS bf16_t* Ks = (const LAS bf16_t*)(lds + (j & 1) * BUFB); const LAS bf16_t* Vt = Ks + 64 * KST; const LAS float* Cs = (const LAS float*)(Vt + 64 * 72);
            f32x16 s0, s1;
#pragma unroll
            for (int r = 0; r < 16; ++r) { s0[r] = 0.f; s1[r] = 0.f; }
#pragma unroll
            for (int ds = 0; ds < NDS; ++ds) {
                const bf16x8 a0 = *(const LAS bf16x8*)(Ks + qi * KST + ds * 16 + 8 * half);
                const bf16x8 a1 = *(const LAS bf16x8*)(Ks + (32 + qi) * KST + ds * 16 + 8 * half);
                s0 = __builtin_amdgcn_mfma_f32_32x32x16_bf16(a0, qf[ds], s0, 0, 0, 0);
                s1 = __builtin_amdgcn_mfma_f32_32x32x16_bf16(a1, qf[ds], s1, 0, 0, 0);
            }
            const bool need_mask = (j == 1) || (j * 64 + 63 > q0);
            float mx = -1e30f;
#pragma unroll
            for (int g = 0; g < 4; ++g) {
                f32x4 c0v = (f32x4){0.f, 0.f, 0.f, 0.f}, c1v = c0v;
                if (FOX) { c0v = *(const LAS f32x4*)(Cs + g * 8 + half * 4); c1v = *(const LAS f32x4*)(Cs + 32 + g * 8 + half * 4); }
#pragma unroll
                for (int e = 0; e < 4; ++e) { const int r = g * 4 + e; const int kl = g * 8 + half * 4 + e;
                    float x0 = s0[r] * c1, x1 = s1[r] * c1;
                    if (FOX) { x0 += cq - c0v[e]; x1 += cq - c1v[e]; }
                    if (need_mask) { const int key0 = j * 64 + kl, key1 = key0 + 32;
                        if (key0 < PADL || key0 > tq) x0 = -1e30f;
                        if (key1 < PADL || key1 > tq) x1 = -1e30f; }
                    s0[r] = x0; s1[r] = x1; mx = fmaxf(mx, fmaxf(x0, x1)); }
            }
            mx = fmaxf(mx, __shfl_xor(mx, 32));
            const float mnew = fmaxf(mrow, mx), alpha = __builtin_amdgcn_exp2f(mrow - mnew);
            float rs = 0.f;
#pragma unroll
            for (int r = 0; r < 16; ++r) { s0[r] = __builtin_amdgcn_exp2f(s0[r] - mnew); s1[r] = __builtin_amdgcn_exp2f(s1[r] - mnew); rs += s0[r] + s1[r]; }
            rs += __shfl_xor(rs, 32);
            lrow = lrow * alpha + rs; mrow = mnew;
#pragma unroll
            for (int r = 0; r < 16; ++r) { o0[r] *= alpha; o1[r] *= alpha; }
#pragma unroll
            for (int s = 0; s < 4; ++s) {
                bf16x8 pf;
                {
                    unsigned w[4];
#pragma unroll
                    for (int e = 0; e < 4; ++e) { const int r = 8 * (s & 1) + 2 * e; w[e] = (s < 2) ? cvt_pk_bf16(s0[r], s0[r + 1]) : cvt_pk_bf16(s1[r], s1[r + 1]); }
                    u32x4 ww = (u32x4){w[0], w[1], w[2], w[3]}; pf = *(bf16x8*)&ww;
                }
                const bf16x8 v0 = *(const LAS bf16x8*)(Vt + qi * 72 + 16 * s + 8 * half);
                const bf16x8 v1 = *(const LAS bf16x8*)(Vt + (32 + qi) * 72 + 16 * s + 8 * half);
                o0 = __builtin_amdgcn_mfma_f32_32x32x16_bf16(v0, pf, o0, 0, 0, 0);
                o1 = __builtin_amdgcn_mfma_f32_32x32x16_bf16(v1, pf, o1, 0, 0, 0);
            }
        }
        __syncthreads();
    }
#undef ATT_PREFETCH
#undef ATT_WRITE
    if (tq < TT) {
        const float inv = (tq >= PADL && lrow > 0.f) ? 1.0f / lrow : 0.f;
        bf16_t* orow = Op + (size_t)tq * 1024;
#pragma unroll
        for (int g = 0; g < 4; ++g) {
            u32x2 w; w.x = cvt_pk_bf16(o0[4 * g] * inv, o0[4 * g + 1] * inv); w.y = cvt_pk_bf16(o0[4 * g + 2] * inv, o0[4 * g + 3] * inv);
            *(u32x2*)(orow + 8 * g + 4 * half) = w;
            w.x = cvt_pk_bf16(o1[4 * g] * inv, o1[4 * g + 1] * inv); w.y = cvt_pk_bf16(o1[4 * g + 2] * inv, o1[4 * g + 3] * inv);
            *(u32x2*)(orow + 32 + 8 * g + 4 * half) = w;
        }
    }
}
__device__ __forceinline__ void phase_attn(const KP& p, LAS unsigned char* lds, int vb, int nvb, int kinds) {
    const bf16_t* P = (const bf16_t*)(p.ws + OFF_BIG);
    const bf16_t* Qm = (const bf16_t*)(p.ws + OFF_QM); const bf16_t* Km = (const bf16_t*)(p.ws + OFF_KM);
    const bf16_t* VTM = (const bf16_t*)(p.out + OO_VM); const bf16_t* VTF = (const bf16_t*)(p.ws + OFF_VTF);
    const float* cum = (const float*)(p.ws + OFF_CUM);
    bf16_t* YS = (bf16_t*)(p.out + OO_YS);
    const int per = (kinds == 3) ? 128 : 64, nitems = 17 * per;
    for (int rnd = 0;; ++rnd) {
        const int idx = rnd * nvb + ((rnd & 1) ? (nvb - 1 - vb) : vb);
        if (rnd * nvb >= nitems) break;
        if (idx >= nitems) continue;
        const int qt = 16 - idx / per; const int rem = idx % per;
        int kind, bh;
        if (kinds == 3) { kind = rem & 1; bh = rem >> 1; } else { kind = (kinds == 2); bh = rem; }
        const int b = bh >> 2, h = bh & 3;
        if (kind == 0)
            attn_item<64, true>(lds, P + (size_t)b * TT * PN + PC_FQ + h * 64, PN, P + (size_t)b * TT * PN + PC_FK + h * 64, PN, VTF + (size_t)bh * 64 * TT,
                                cum + (size_t)bh * TT, nullptr, 0.125f * LOG2E, YS + (size_t)b * TT * 1024 + h * 64, qt);
        else
            attn_item<96, false>(lds, Qm + (size_t)b * TT * 384 + h * 96, 384, Km + (size_t)b * TT * 384 + h * 96, 384, VTM + (size_t)bh * 64 * TT,
                                 nullptr, (const float*)(p.ws + OFF_ROPE), 0.10206207261596577f * LOG2E, YS + (size_t)b * TT * 1024 + 256 + h * 64, qt);
    }
    __syncthreads();
}

constexpr int NPL = 13, NPH = 2 + 2 * NPL;

template <int ph>
__device__ __forceinline__ void run_phase(const KP& p, LAS unsigned char* lds) {
    const int G = ogdim(), c = obid();
    char* ws = p.ws;
    int kind = -1, l = 0;
    int s = -1;
    if (ph == 0) { if (EN_MASK & 1) phase_prep(p, lds); phase_rmsnorm(p, nullptr, 2); return; }
    if (ph == NPH - 1) { phase_rmsnorm(p, p.inp(30), 3); return; }
    l = (ph - 1) / NPL; s = (ph - 1) % NPL;
    const char* W = ws + OFF_W + (size_t)l * W_LAYER;
    pg8::ssq_t* SSb = (pg8::ssq_t*)(ws + OFF_SS);
    const pg8::ssq_t* SS = SSb + (size_t)NT * ((s == 0) ? 3 * l : (s == 11) ? 3 * l + 2 : 3 * l + 1);
    pg8::ssq_t* SSw = SSb + (size_t)NT * ((s == 1) ? 3 * l + 1 : (s == 10) ? 3 * l + 2 : (3 * l + 3) % 6);
    pg8::Sched S;
    const void* gA = nullptr; const void* gB = nullptr; int gK = 0, lda = 0, ldb = 0, half = 0; float alpha = 0.f;
    switch (s) {
    case 0: kind = 0; gA = ws + OFF_UN; gB = W + W_WI1; break;
    case 11: kind = 0; gA = ws + OFF_UN; gB = W + W_WI2; break;
    case 1: kind = 1; gA = ws + OFF_BIG; gB = W + W_WO1; gK = FF; lda = FF; ldb = FF; alpha = 0.5f; break;
    case 12: kind = 1; gA = ws + OFF_BIG; gB = W + W_WO2; gK = FF; lda = FF; ldb = FF; alpha = 0.5f; break;
    case 10: kind = 1; gA = ws + OFF_MERGED; gB = W + W_WOUT; gK = DM; lda = DM; ldb = DM; alpha = 1.0f; break;
    case 2: kind = 2; break;
    case 3: {
        phase_mla_pre(p, l);
        if (c >= 128 && c < 192) fox_cum_item(p, l, lds, c - 128);
        if (c < 64) { if (EN_MASK & 2) lru_item(p, l, lds, c); }
        else if (EN_MASK & 4) { for (int pr = c - 64; pr < NB * 4 * 33; pr += G - 64) gdn_pre_pair(p, l, lds, pr); }
        return; }
    case 4: kind = 3; break;
    case 5: if (EN_MASK & 8) phase_attn(p, lds, c, G, 2); return;
    case 6: kind = 4; half = 0; break;
    case 8: kind = 4; half = 1; break;
    case 7: kind = 5; half = 0; break;
    case 9: kind = 5; half = 1; break;
    default: return;
    }
    if (!(EN_MASK & 32)) return;
    if (!((GK_MASK >> kind) & 1)) return;
    switch (kind) {
    case 0: if ((GK_MASK >> 0) & 1) { S.init(NT / 256, 2 * FF / 256, G, c, 0, gA, DM, gB, DM); pg8::EpiSwiglu E{(bf16_t*)(ws + OFF_BIG), SS}; pg8::gemm_phase(lds, DM, DM, DM, S, E); break; }
    case 1: if ((GK_MASK >> 1) & 1) { S.init(NT / 256, DM / 256, G, c, 0, gA, lda, gB, ldb); pg8::EpiResid E{(float*)(ws + OFF_H), alpha, (bf16_t*)(ws + OFF_UN), SSw}; pg8::gemm_phase(lds, gK, lda, ldb, S, E); break; }
    case 2: if ((GK_MASK >> 2) & 1) { S.init(NT / 256, PN / 256, G, c, 0, ws + OFF_UN, DM, W + W_WIN, DM); pg8::EpiBf16 E{(bf16_t*)(ws + OFF_BIG), PN, 0, (bf16_t*)(ws + OFF_VTF), SS}; pg8::gemm_phase(lds, DM, DM, DM, S, E); break; }
    case 3: if ((GK_MASK >> 3) & 1) {
              if (c < 64) { if (EN_MASK & 16) gdn_scan_item(p, l, lds, c); }
              else { S.init(NT / 256, 4, G - 64, c - 64, 0, ws + OFF_AMLA, 384, W + W_WUP, 384);
                  pg8::EpiMlaUp E{(bf16_t*)(ws + OFF_QM), (bf16_t*)(ws + OFF_KM), (bf16_t*)(p.out + OO_VM)}; pg8::gemm_phase(lds, 384, 384, 384, S, E);
                  __syncthreads();
                  if (EN_MASK & 8) phase_attn(p, lds, c - 64, G - 64, 1); }
              break; }
    case 4: if ((GK_MASK >> 4) & 1) { S.init((half ? HR : HR0) / 256, 16, G, c, 1, p.out + OO_YS + (size_t)half * HR0 * 1024 * 2, 1024, W + W_WB, 256);
              pg8::EpiBf16 E{(bf16_t*)(ws + OFF_BIG), 1024, 1, nullptr, nullptr}; pg8::gemm_phase(lds, 256, 1024, 256, S, E); break; }
    case 5: if ((GK_MASK >> 5) & 1) { S.init((half ? HR : HR0) / 256, 16, G, c, 0, ws + OFF_UN + (size_t)half * HR0 * DM * 2, DM, W + W_WG, DM);
              pg8::EpiGate E{(bf16_t*)(ws + OFF_MERGED), (const bf16_t*)(ws + OFF_BIG), p.inp(24) + (size_t)l * 4 * DM, half * HR0, SS}; pg8::gemm_phase(lds, DM, DM, DM, S, E); break; }
    default: break;
    }
}

__device__ __forceinline__ void grid_bar(unsigned* ctr, unsigned target) {
    __syncthreads();
    if (threadIdx.x == 0) {
        __threadfence();
        __hip_atomic_fetch_add(ctr, 1u, __ATOMIC_RELAXED, __HIP_MEMORY_SCOPE_AGENT);
        while (__hip_atomic_load(ctr, __ATOMIC_RELAXED, __HIP_MEMORY_SCOPE_AGENT) < target) __builtin_amdgcn_s_sleep(1);
        __threadfence();
    }
    __syncthreads();
}
template <int PH>
__device__ __forceinline__ void run_all(const KP& p, LAS unsigned char* lds) {
    if constexpr (PH < NPH) {
        run_phase<PH>(p, lds);
        if constexpr (PH == 0) { if (blockIdx.x == 0 && threadIdx.x == 0) { *(unsigned*)(p.ws + OFF_CTR) = 0u; __threadfence(); } cg::this_grid().sync(); }
        else if constexpr (PH + 1 < NPH) grid_bar((unsigned*)(p.ws + OFF_CTR), (unsigned)PH * gridDim.x);
        run_all<PH + 1>(p, lds);
    }
}
__global__ void __launch_bounds__(NTHR, 2) mega_kernel(KPA pa) {
    extern __shared__ __attribute__((aligned(16))) unsigned char smem[];
    LAS unsigned char* lds = (LAS unsigned char*)smem;
    KP p;
#pragma unroll
    for (int i = 0; i < 31; ++i) p.in[i] = pa.in[i];
    p.ws = pa.ws; p.out = pa.out; p.lo = 0; p.hi = 0;
    run_all<0>(p, lds);
}

extern "C" void kernel_launch(void* const* d_in, const int* in_sizes, int n_in, void* d_out, int out_size, void* d_ws, size_t ws_size, hipStream_t stream) {
    static int grid = 0;
    if (grid == 0) {
        if (n_in != 31 || ws_size < WS_END) { fprintf(stderr, "kernel_launch: unexpected n_in %d / ws %zu (need %zu)\n", n_in, ws_size, (size_t)WS_END); grid = -1; return; }
        int dev = 0, cus = 0, per_cu = 0;
        hipGetDevice(&dev); hipDeviceGetAttribute(&cus, hipDeviceAttributeMultiprocessorCount, dev);
        if (hipFuncSetAttribute((const void*)mega_kernel, hipFuncAttributeMaxDynamicSharedMemorySize, LDS_BYTES) != hipSuccess) { fprintf(stderr, "kernel_launch: hipFuncSetAttribute failed\n"); grid = -1; return; }
        if (hipOccupancyMaxActiveBlocksPerMultiprocessor(&per_cu, (const void*)mega_kernel, NTHR, LDS_BYTES) != hipSuccess || per_cu < 1) { fprintf(stderr, "kernel_launch: occupancy query says %d\n", per_cu); per_cu = 1; }
        (void)hipGetLastError();
        grid = cus;
    }
    if (grid < 0) return;
    KPA a; memset(&a, 0, sizeof(a));
    for (int i = 0; i < 31; ++i) a.in[i] = (const float*)d_in[i];
    a.ws = (char*)d_ws; a.out = (char*)d_out;
    a.lo = 0; a.hi = NPH;
    void* args[] = {&a};
    hipError_t e = hipLaunchCooperativeKernel((const void*)mega_kernel, dim3(grid), dim3(NTHR), args, LDS_BYTES, stream);
    if (e != hipSuccess) fprintf(stderr, "cooperative launch failed: %s (grid %d)\n", hipGetErrorString(e), grid);
}
```
